# Optimizing an MI355X kernel written in HIP

```python
import math
import jax, jax.numpy as jnp
from jax import lax
import numpy as np

D_MODEL = 1024
BATCH = 8
SEQ = 2048
DEPTH = 1

GLA_HEADS = 4
GLA_DK = D_MODEL // 2
GLA_DV = D_MODEL
GLA_HK = GLA_DK // GLA_HEADS
GLA_HV = GLA_DV // GLA_HEADS
GLA_RANK = 16
GLA_TAU = 16.0
GLA_CHUNK = 64
SB_HEADS = 8
SB_WIDTH = D_MODEL
SB_HD = SB_WIDTH // SB_HEADS
SB_BLOCK = 128
N_BRANCH = 2
EPS = 1e-6

SPLIT_SIZES = [GLA_DK, GLA_DK, GLA_DV, GLA_DV, GLA_RANK,
               SB_WIDTH, SB_WIDTH, SB_WIDTH, SB_WIDTH, N_BRANCH * D_MODEL]
SPLIT_IDX = [int(v) for v in np.cumsum(SPLIT_SIZES)[:-1]]
IN_COLS = int(sum(SPLIT_SIZES))

kernel_name = "gla_stickbreaking_gated_hybrid"


def rmsnorm(x, g):
    xf = x.astype(jnp.float32)
    y = xf * lax.rsqrt(jnp.mean(xf * xf, axis=-1, keepdims=True) + EPS)
    return y.astype(x.dtype) * g


def gla_chunked(q, k, v, log_a):
    B, T, H, dk = q.shape
    dv = v.shape[-1]
    C = GLA_CHUNK
    n = T // C
    def to_chunks(a):
        return a.reshape(B, n, C, H, a.shape[-1]).transpose(0, 3, 1, 2, 4).astype(jnp.float32)
    qc, kc, vc, la = to_chunks(q), to_chunks(k), to_chunks(v), to_chunks(log_a)
    bcum = jnp.cumsum(la, axis=3)
    b_last = bcum[:, :, :, -1:, :]
    qe = qc * jnp.exp(bcum) * (dk ** -0.5)
    ke = kc * jnp.exp(-bcum)
    kd = kc * jnp.exp(b_last - bcum)
    mask = jnp.tril(jnp.ones((C, C), jnp.float32))
    attn = jnp.einsum('bhnid,bhnjd->bhnij', qe, ke) * mask
    o_intra = jnp.einsum('bhnij,bhnjv->bhniv', attn, vc)

    def step(S, inp):
        q_i, k_i, v_i, d_i = inp
        o = jnp.einsum('bhid,bhdv->bhiv', q_i, S)
        S = d_i[..., None] * S + jnp.einsum('bhjd,bhjv->bhdv', k_i, v_i)
        return S, o

    xs = (jnp.moveaxis(qe, 2, 0), jnp.moveaxis(kd, 2, 0), jnp.moveaxis(vc, 2, 0),
          jnp.moveaxis(jnp.exp(b_last[:, :, :, 0, :]), 2, 0))
    S0 = jnp.zeros((B, H, dk, dv), jnp.float32)
    _, o_inter = lax.scan(step, S0, xs)
    o = o_intra + jnp.moveaxis(o_inter, 0, 2)
    return o.transpose(0, 2, 3, 1, 4).reshape(B, T, H, dv)


def stick_breaking(q, k, v):
    B, T, H, d = q.shape
    qh = q.transpose(0, 2, 1, 3)
    kh = k.transpose(0, 2, 1, 3)
    vh = v.transpose(0, 2, 1, 3)
    scale = 1.0 / math.sqrt(d)
    outs = []
    for i in range(T // SB_BLOCK):
        L = (i + 1) * SB_BLOCK
        qb = qh[:, :, i * SB_BLOCK:L]
        z = jnp.einsum('bhqd,bhkd->bhqk', qb, kh[:, :, :L]).astype(jnp.float32) * scale
        tpos = i * SB_BLOCK + jnp.arange(SB_BLOCK)[:, None]
        spos = jnp.arange(L)[None, :]
        causal = spos < tpos
        log1m = jnp.where(causal, jax.nn.log_sigmoid(-z), 0.0)
        between = lax.cumsum(log1m, axis=3, reverse=True) - log1m
        A = jnp.where(causal, jnp.exp(jax.nn.log_sigmoid(z) + between), 0.0)
        outs.append(jnp.einsum('bhqk,bhkd->bhqd', A.astype(vh.dtype), vh[:, :, :L]))
    o = jnp.concatenate(outs, axis=2)
    return o.transpose(0, 2, 1, 3)


def setup_inputs(seed: int = 0) -> dict:
    key = jax.random.key(seed)
    ks = jax.random.split(key, 12)
    f = jnp.float32
    x = jax.random.normal(ks[0], (BATCH, SEQ, D_MODEL), f)
    norm_g = 1.0 + 0.02 * jax.random.normal(ks[1], (D_MODEL,), f)
    w_in = jax.random.normal(ks[2], (D_MODEL, IN_COLS), f) * D_MODEL ** -0.5
    w_dec_up = jax.random.normal(ks[3], (GLA_RANK, GLA_DK), f) * GLA_RANK ** -0.5
    b_dec = 0.1 * jax.random.normal(ks[4], (GLA_DK,), f)
    gla_norm_g = 1.0 + 0.02 * jax.random.normal(ks[5], (GLA_HV,), f)
    w_pa = jax.random.normal(ks[6], (GLA_DV, D_MODEL), f) * GLA_DV ** -0.5
    w_pb = jax.random.normal(ks[7], (SB_WIDTH, D_MODEL), f) * SB_WIDTH ** -0.5
    b_gate = 0.01 * jax.random.normal(ks[8], (N_BRANCH * D_MODEL,), f)
    w_o = jax.random.normal(ks[9], (D_MODEL, D_MODEL), f) * D_MODEL ** -0.5
    final_g = 1.0 + 0.02 * jax.random.normal(ks[10], (D_MODEL,), f)
    return {"x": x, "norm_g": norm_g, "w_in": w_in, "w_dec_up": w_dec_up, "b_dec": b_dec,
            "gla_norm_g": gla_norm_g, "w_pa": w_pa, "w_pb": w_pb, "b_gate": b_gate,
            "w_o": w_o, "final_g": final_g}


def reference(x, norm_g, w_in, w_dec_up, b_dec, gla_norm_g, w_pa, w_pb, b_gate, w_o, final_g):
    B, T, _ = x.shape
    for _layer in range(DEPTH):
        h = rmsnorm(x, norm_g)
        proj = h @ w_in
        (g_q, g_k, g_v, g_gate, g_rank,
         s_q, s_k, s_v, s_gate, m_logits) = jnp.split(proj, SPLIT_IDX, axis=-1)

        log_a = jax.nn.log_sigmoid((g_rank @ w_dec_up + b_dec).astype(jnp.float32)) / GLA_TAU
        o_gla = gla_chunked(g_q.reshape(B, T, GLA_HEADS, GLA_HK),
                            g_k.reshape(B, T, GLA_HEADS, GLA_HK),
                            g_v.reshape(B, T, GLA_HEADS, GLA_HV),
                            log_a.reshape(B, T, GLA_HEADS, GLA_HK)).astype(x.dtype)
        o_gla = rmsnorm(o_gla, gla_norm_g).reshape(B, T, GLA_DV) * jax.nn.silu(g_gate)
        y_a = o_gla @ w_pa

        o_sb = stick_breaking(s_q.reshape(B, T, SB_HEADS, SB_HD),
                              s_k.reshape(B, T, SB_HEADS, SB_HD),
                              s_v.reshape(B, T, SB_HEADS, SB_HD))
        o_sb = o_sb.reshape(B, T, SB_WIDTH) * jax.nn.silu(s_gate)
        y_b = o_sb @ w_pb

        gates = jax.nn.sigmoid(m_logits + b_gate).reshape(B, T, N_BRANCH, D_MODEL)
        merged = gates[:, :, 0] * y_a + gates[:, :, 1] * y_b
        x = x + merged @ w_o
    return rmsnorm(x, final_g)
```

```cpp
#include <hip/hip_runtime.h>
#include <hip/hip_cooperative_groups.h>
#include <cstdio>
#include <cstdint>
namespace cg = cooperative_groups;

#define LAS __attribute__((address_space(3)))
#define GAS __attribute__((address_space(1)))
typedef unsigned short bf16_t;
typedef short bf16x8 __attribute__((ext_vector_type(8)));
typedef float f32x4 __attribute__((ext_vector_type(4)));
typedef float f32x2 __attribute__((ext_vector_type(2)));
typedef unsigned u32x4 __attribute__((ext_vector_type(4)));
typedef unsigned u32x2 __attribute__((ext_vector_type(2)));

constexpr int D = 1024, BATCH = 8, SEQ = 2048, M = BATCH * SEQ;
constexpr int IN_COLS = 9232, RANK_OFF = 3072, NP = 9216;
constexpr int N1 = 7168;
constexpr float EPS = 1e-6f;
constexpr int NWAVES = 8, NTHREADS = 512;

constexpr size_t MiB = 1u << 20;
constexpr size_t WS_RANK = 1 * MiB;
constexpr size_t WS_WIN = 2 * MiB;
constexpr size_t WS_WPAB = 20 * MiB;
constexpr size_t WS_WO = 24 * MiB;
constexpr size_t WS_ACT = 32 * MiB;
constexpr size_t ACT_STRIDE = 32 * MiB;
constexpr int B_GQK = 0, B_GV = 1, B_GG = 2, B_SQ = 3, B_SK = 4, B_SV = 5, B_SG = 6;
constexpr int LDS_BYTES = 147456;

typedef __bf16 bf16x2_hw __attribute__((ext_vector_type(2)));
__device__ __forceinline__ unsigned pk2(float lo, float hi) { f32x2 v = {lo, hi}; bf16x2_hw b = __builtin_convertvector(v, bf16x2_hw); return __builtin_bit_cast(unsigned, b); }
__device__ __forceinline__ unsigned f2bf(float f) { return pk2(f, 0.f) & 0xffffu; }
__device__ __forceinline__ float bf2f(unsigned short b) { return __builtin_bit_cast(float, (unsigned)b << 16); }
__device__ __forceinline__ float bflo(unsigned w) { return __builtin_bit_cast(float, w << 16); }
__device__ __forceinline__ float bfhi(unsigned w) { return __builtin_bit_cast(float, w & 0xffff0000u); }
__device__ __forceinline__ unsigned cvt_pk_bf16(float lo, float hi) { unsigned r; asm volatile("v_cvt_pk_bf16_f32 %0, %1, %2" : "=v"(r) : "v"(lo), "v"(hi)); return r; }
__device__ __forceinline__ float wave_sum(float v) {
#pragma unroll
    for (int o = 1; o < 64; o <<= 1) v += __shfl_xor(v, o);
    return v;
}
__device__ __forceinline__ float sigmoidf_(float v) { return __builtin_amdgcn_rcpf(1.f + __expf(-v)); }
__device__ __forceinline__ float siluf_(float v) { return v * __builtin_amdgcn_rcpf(1.f + __expf(-v)); }
#define LDS_WAIT() asm volatile("s_waitcnt lgkmcnt(0)" ::: "memory")

namespace pg8 {
constexpr int BM = 256, BK = 64, HALF = 128, HTB = HALF * BK * 2, STAGE_BYTES = 8 * HTB, NXCD = 8, WGM = 8;
__host__ __device__ __forceinline__ int lds_byte(int r, int c) { const int st = (r >> 4) * 2 + (c >> 5), rr = r & 15, cc = c & 31, ob = rr * 64 + cc * 2; return st * 1024 + (ob ^ (((ob >> 9) & 1) << 5)); }
__host__ __device__ __forceinline__ void stage_rc(int b, int& R, int& C) { const int st = b / 1024, sb = b % 1024, swz = sb ^ (((sb >> 9) & 1) << 5); R = (st >> 1) * 16 + swz / 64; C = (st & 1) * 32 + (swz % 64) / 2; }
__host__ __device__ __forceinline__ int perm32(int rho) { const int n = rho >> 4, i = rho & 15; return 8 * (i >> 2) + 4 * n + (i & 3); }

struct Unit { int pm, pn, kind; };
__device__ __forceinline__ void zero_acc(f32x4 (&acc)[2][2][4][2]) {
#pragma unroll
    for (int a = 0; a < 2; ++a)
#pragma unroll
        for (int b = 0; b < 2; ++b)
#pragma unroll
            for (int m = 0; m < 4; ++m)
#pragma unroll
                for (int n = 0; n < 2; ++n) acc[a][b][m][n] = (f32x4){0.f, 0.f, 0.f, 0.f};
}

struct Sched {
    int nM, nN, nwg, G, c, reps, split;
    const char* A0; const char* A1; const char* A2; const char* A3;
    const char* B0; const char* B1; const char* B2; const char* B3;
    __device__ __forceinline__ bool next(int i, Unit& u) const {
        const int ti = i / reps; u.kind = i - ti * reps;
        const long L = (long)ti * G + c; if (L >= nwg) return false;
        int wgid = (int)L; { const int q = nwg / NXCD, r = nwg % NXCD, xcd = wgid % NXCD, off = wgid / NXCD; wgid = (xcd < r ? xcd * (q + 1) : r * (q + 1) + (xcd - r) * q) + off; }
        const int nig = WGM * nN, gid = wgid / nig, fm = gid * WGM, gsz = (nM - fm) < WGM ? (nM - fm) : WGM;
        u.pm = fm + ((wgid % nig) % gsz); u.pn = (wgid % nig) / gsz;
        if (split > 0 && u.pn >= split) { u.kind = 1; u.pn -= split; }
        return true;
    }
    __device__ __forceinline__ const char* aptr(const Unit& u) const { const char* b = u.kind == 0 ? A0 : (u.kind == 1 ? A1 : (u.kind == 2 ? A2 : A3)); return b + (size_t)u.pm * (256 * 1024 * 2); }
    __device__ __forceinline__ const char* bptr(const Unit& u) const { const char* b = u.kind == 0 ? B0 : (u.kind == 1 ? B1 : (u.kind == 2 ? B2 : B3)); return b + (size_t)u.pn * (256 * 1024 * 2); }
};

template <class Epi>
__device__ __forceinline__ void gemm_phase(LAS unsigned char* lds, const Sched& S, const Epi& E) {
    const int tid = threadIdx.x, wid = __builtin_amdgcn_readfirstlane(tid >> 6), lane = tid & 63, wr = wid >> 2, wc = wid & 3, fr = lane & 15, fq = lane >> 4;
    constexpr int K = 1024, nt = K / BK;
    unsigned voffA[2], voffB[2];
#pragma unroll
    for (int i = 0; i < 2; ++i) { int R, C; stage_rc(tid * 16 + i * 8192, R, C); const int Rb = (R & ~31) + perm32(R & 31);
        voffA[i] = (unsigned)(R * K + C) * 2u; voffB[i] = (unsigned)(Rb * K + C) * 2u; }
    const size_t kstep = (size_t)(BK * 2);
    const size_t hstep = (size_t)HALF * K * 2;
    const unsigned ldsw = (unsigned)wid * 1024u;
    const int aoff = lds_byte(wr * 64 + fr, fq * 8), boff = lds_byte(wc * 32 + fr, fq * 8);
#define PG8_SA(b, h) (((b) * 2 + (h)) * HTB)
#define PG8_SB(b, h) ((4 + (b) * 2 + (h)) * HTB)
#define PG8_STAGE(bufoff, gbase, voff) do { _Pragma("unroll") for (int _i = 0; _i < 2; ++_i) \
        __builtin_amdgcn_global_load_lds((const unsigned*)((const char*)(gbase) + (voff)[_i]), (LAS unsigned*)(lds + (bufoff) + ldsw + _i * 8192), 16, 0, 0); } while (0)
#define PG8_LDA(dst, b, h) do { _Pragma("unroll") for (int m = 0; m < 4; ++m) _Pragma("unroll") for (int k = 0; k < 2; ++k) dst[m][k] = *(const LAS bf16x8*)(lds + PG8_SA(b, h) + aoff + m * 2048 + k * 1024); } while (0)
#define PG8_LDB(dst, b, h) do { _Pragma("unroll") for (int n = 0; n < 2; ++n) _Pragma("unroll") for (int k = 0; k < 2; ++k) dst[n][k] = *(const LAS bf16x8*)(lds + PG8_SB(b, h) + boff + n * 2048 + k * 1024); } while (0)
#define PG8_MMA(ai, bj, At, Bt) do { __builtin_amdgcn_s_setprio(1); _Pragma("unroll") for (int m = 0; m < 4; ++m) _Pragma("unroll") for (int n = 0; n < 2; ++n) _Pragma("unroll") for (int k = 0; k < 2; ++k) \
        acc[ai][bj][m][n] = __builtin_amdgcn_mfma_f32_16x16x32_bf16(Bt[n][k], At[m][k], acc[ai][bj][m][n], 0, 0, 0); __builtin_amdgcn_s_setprio(0); } while (0)
#define PG8_WAIT_V(n) asm volatile("s_waitcnt vmcnt(" #n ")" ::: "memory")
#define PG8_WAIT_L(n) asm volatile("s_waitcnt lgkmcnt(" #n ")" ::: "memory")
#define PG8_BAR __builtin_amdgcn_s_barrier()
#define PG8_SCHED __builtin_amdgcn_sched_barrier(0)
    Unit cur, nxt; int ui = 0;
    if (!S.next(0, cur)) return;
    f32x4 acc[2][2][4][2];
#pragma unroll
    for (int a = 0; a < 2; ++a)
#pragma unroll
        for (int b = 0; b < 2; ++b)
#pragma unroll
            for (int m = 0; m < 4; ++m)
#pragma unroll
                for (int n = 0; n < 2; ++n) acc[a][b][m][n] = (f32x4){0.f, 0.f, 0.f, 0.f};
    bf16x8 At[4][2], B0[2][2], B1[2][2];
    const char* cA = S.aptr(cur); const char* cB = S.bptr(cur);
    PG8_STAGE(PG8_SB(0, 0), cB, voffB); PG8_STAGE(PG8_SB(0, 1), cB + hstep, voffB); PG8_STAGE(PG8_SA(0, 0), cA, voffA); PG8_STAGE(PG8_SA(0, 1), cA + hstep, voffA);
    if (wr == 1) PG8_BAR;
    PG8_WAIT_V(2); PG8_BAR;
    PG8_STAGE(PG8_SB(1, 0), cB + kstep, voffB); PG8_STAGE(PG8_SA(1, 0), cA + kstep, voffA); PG8_STAGE(PG8_SB(1, 1), cB + hstep + kstep, voffB);
    PG8_WAIT_V(6); PG8_BAR;
    for (;;) {
        const bool has_next = S.next(ui + 1, nxt);
        const char* nA = has_next ? S.aptr(nxt) : cA; const char* nB = has_next ? S.bptr(nxt) : cB;
        for (int t = 0; t < nt; t += 2) {
            const bool last = (t == nt - 2);
            const char* a1 = cA + (size_t)(t + 1) * kstep;
            const char* a2 = last ? nA : cA + (size_t)(t + 2) * kstep; const char* b2 = last ? nB : cB + (size_t)(t + 2) * kstep;
            const char* a3 = a2 + kstep; const char* b3 = b2 + kstep;
            PG8_LDB(B0, 0, 0); PG8_LDB(B1, 0, 1); PG8_SCHED; PG8_LDA(At, 0, 0); PG8_STAGE(PG8_SA(1, 1), a1 + hstep, voffA);
            PG8_WAIT_V(8); PG8_WAIT_L(0); PG8_BAR; PG8_MMA(0, 0, At, B0); PG8_MMA(0, 1, At, B1); PG8_BAR; PG8_SCHED;
            PG8_LDA(At, 0, 1); PG8_STAGE(PG8_SB(0, 0), b2, voffB); PG8_STAGE(PG8_SB(0, 1), b2 + hstep, voffB); PG8_STAGE(PG8_SA(0, 0), a2, voffA);
            PG8_WAIT_V(8); PG8_WAIT_L(0); PG8_BAR; PG8_MMA(1, 0, At, B0); PG8_MMA(1, 1, At, B1); PG8_BAR; PG8_SCHED;
            PG8_LDB(B0, 1, 0); PG8_LDB(B1, 1, 1); PG8_SCHED; PG8_LDA(At, 1, 0); PG8_STAGE(PG8_SA(0, 1), a2 + hstep, voffA);
            PG8_WAIT_V(8); PG8_WAIT_L(0); PG8_BAR; PG8_MMA(0, 0, At, B0); PG8_MMA(0, 1, At, B1); PG8_BAR; PG8_SCHED;
            PG8_LDA(At, 1, 1); PG8_STAGE(PG8_SB(1, 0), b3, voffB); PG8_STAGE(PG8_SB(1, 1), b3 + hstep, voffB); PG8_STAGE(PG8_SA(1, 0), a3, voffA);
            PG8_WAIT_V(8); PG8_WAIT_L(0); PG8_BAR; PG8_MMA(1, 0, At, B0); PG8_MMA(1, 1, At, B1); PG8_BAR; PG8_SCHED;
        }
        if (wr == 0) PG8_BAR;
        E(acc, cur, wr, wc, fr, fq);
        if (!has_next) break;
        zero_acc(acc);
        cur = nxt; cA = nA; cB = nB; ++ui;
        if (wr == 1) PG8_BAR;
    }
    PG8_WAIT_V(0);
    PG8_BAR;
#undef PG8_SA
#undef PG8_SB
#undef PG8_STAGE
#undef PG8_LDA
#undef PG8_LDB
#undef PG8_MMA
#undef PG8_WAIT_V
#undef PG8_WAIT_L
#undef PG8_BAR
#undef PG8_SCHED
}

struct EpiProj {
    bf16_t* act;
    __device__ __forceinline__ bool operator()(const f32x4 (&acc)[2][2][4][2], const Unit& u, int wr, int wc, int fr, int fq) const {
        const int t = u.pn >> 2; const bool gate = (t == B_GG) || (t == B_SG);
        bf16_t* base = act + (size_t)t * (ACT_STRIDE / 2);
        const int row0 = u.pm * BM + wr * 64 + fr, col0 = (u.pn & 3) * 256 + wc * 32 + 8 * fq;
#pragma unroll
        for (int ai = 0; ai < 2; ++ai)
#pragma unroll
            for (int m = 0; m < 4; ++m) { bf16_t* rowp = base + (size_t)(row0 + ai * HALF + m * 16) * 1024 + col0;
#pragma unroll
                for (int bj = 0; bj < 2; ++bj) { f32x4 v0 = acc[ai][bj][m][0], v1 = acc[ai][bj][m][1];
                    if (gate) {
#pragma unroll
                        for (int e = 0; e < 4; ++e) { v0[e] = siluf_(v0[e]); v1[e] = siluf_(v1[e]); } }
                    u32x4 w; w.x = cvt_pk_bf16(v0[0], v0[1]); w.y = cvt_pk_bf16(v0[2], v0[3]); w.z = cvt_pk_bf16(v1[0], v1[1]); w.w = cvt_pk_bf16(v1[2], v1[3]);
                    *(u32x4*)(rowp + bj * HALF) = w; } }
        return false;
    }
};
struct EpiMerge {
    const unsigned char* ga; const unsigned char* gb; bf16_t* merged;
    __device__ __forceinline__ bool operator()(const f32x4 (&acc)[2][2][4][2], const Unit& u, int wr, int wc, int fr, int fq) const {
        const int row0 = u.pm * BM + wr * 64 + fr, col0 = u.pn * 256 + wc * 32 + 8 * fq;
#pragma unroll
        for (int ai = 0; ai < 2; ++ai)
#pragma unroll
            for (int m = 0; m < 4; ++m) { const size_t off = (size_t)(row0 + ai * HALF + m * 16) * 1024 + col0;
#pragma unroll
                for (int bj = 0; bj < 2; ++bj) {
                    const u32x2 wa = *(const u32x2*)(ga + off + bj * HALF), wb = *(const u32x2*)(gb + off + bj * HALF); const u32x4 wy = *(const u32x4*)(merged + off + bj * HALF);
                    const float k255 = 1.f / 255.f;
                    float g[8] = {(float)(wa.x & 255u) * k255, (float)((wa.x >> 8) & 255u) * k255, (float)((wa.x >> 16) & 255u) * k255, (float)(wa.x >> 24) * k255, (float)(wa.y & 255u) * k255, (float)((wa.y >> 8) & 255u) * k255, (float)((wa.y >> 16) & 255u) * k255, (float)(wa.y >> 24) * k255};
                    float q[8] = {(float)(wb.x & 255u) * k255, (float)((wb.x >> 8) & 255u) * k255, (float)((wb.x >> 16) & 255u) * k255, (float)(wb.x >> 24) * k255, (float)(wb.y & 255u) * k255, (float)((wb.y >> 8) & 255u) * k255, (float)((wb.y >> 16) & 255u) * k255, (float)(wb.y >> 24) * k255};
                    float y[8] = {bflo(wy.x), bfhi(wy.x), bflo(wy.y), bfhi(wy.y), bflo(wy.z), bfhi(wy.z), bflo(wy.w), bfhi(wy.w)};
                    f32x4 v0 = acc[ai][bj][m][0], v1 = acc[ai][bj][m][1];
#pragma unroll
                    for (int e = 0; e < 4; ++e) { v0[e] = v0[e] * g[e] + q[e] * y[e]; v1[e] = v1[e] * g[4 + e] + q[4 + e] * y[4 + e]; }
                    u32x4 w; w.x = cvt_pk_bf16(v0[0], v0[1]); w.y = cvt_pk_bf16(v0[2], v0[3]); w.z = cvt_pk_bf16(v1[0], v1[1]); w.w = cvt_pk_bf16(v1[2], v1[3]);
                    *(u32x4*)(merged + off + bj * HALF) = w; }
                __builtin_amdgcn_sched_barrier(0); }
        return false;
    }
};
struct EpiRaw {
    bf16_t* out;
    __device__ __forceinline__ bool operator()(const f32x4 (&acc)[2][2][4][2], const Unit& u, int wr, int wc, int fr, int fq) const {
        const int row0 = u.pm * BM + wr * 64 + fr, col0 = u.pn * 256 + wc * 32 + 8 * fq;
#pragma unroll
        for (int ai = 0; ai < 2; ++ai)
#pragma unroll
            for (int m = 0; m < 4; ++m) { bf16_t* rowp = out + (size_t)(row0 + ai * HALF + m * 16) * 1024 + col0;
#pragma unroll
                for (int bj = 0; bj < 2; ++bj) { const f32x4 v0 = acc[ai][bj][m][0], v1 = acc[ai][bj][m][1];
                    u32x4 w; w.x = cvt_pk_bf16(v0[0], v0[1]); w.y = cvt_pk_bf16(v0[2], v0[3]); w.z = cvt_pk_bf16(v1[0], v1[1]); w.w = cvt_pk_bf16(v1[2], v1[3]);
                    *(u32x4*)(rowp + bj * HALF) = w; } }
        return false;
    }
};
struct EpiGate {
    unsigned char* ga; unsigned char* gb; const float* b_gate;
    __device__ __forceinline__ bool operator()(const f32x4 (&acc)[2][2][4][2], const Unit& u, int wr, int wc, int fr, int fq) const {
        const int br = u.pn >> 2; unsigned char* base = br == 0 ? ga : gb;
        const int row0 = u.pm * BM + wr * 64 + fr, col0 = (u.pn & 3) * 256 + wc * 32 + 8 * fq; const float* bp = b_gate + br * 1024 + col0;
#pragma unroll
        for (int ai = 0; ai < 2; ++ai)
#pragma unroll
            for (int m = 0; m < 4; ++m) { unsigned char* rowp = base + (size_t)(row0 + ai * HALF + m * 16) * 1024 + col0;
#pragma unroll
                for (int bj = 0; bj < 2; ++bj) { f32x4 v0 = acc[ai][bj][m][0], v1 = acc[ai][bj][m][1];
#pragma unroll
                    for (int e = 0; e < 4; ++e) { v0[e] = sigmoidf_(v0[e] + bp[bj * HALF + e]); v1[e] = sigmoidf_(v1[e] + bp[bj * HALF + 4 + e]); }
                    u32x2 w;
                    w.x = (unsigned)(v0[0] * 255.f + 0.5f) | ((unsigned)(v0[1] * 255.f + 0.5f) << 8) | ((unsigned)(v0[2] * 255.f + 0.5f) << 16) | ((unsigned)(v0[3] * 255.f + 0.5f) << 24);
                    w.y = (unsigned)(v1[0] * 255.f + 0.5f) | ((unsigned)(v1[1] * 255.f + 0.5f) << 8) | ((unsigned)(v1[2] * 255.f + 0.5f) << 16) | ((unsigned)(v1[3] * 255.f + 0.5f) << 24);
                    *(u32x2*)(rowp + bj * HALF) = w; } }
        return false;
    }
};
struct EpiGateYb {
    EpiGate g; EpiRaw r;
    __device__ __forceinline__ bool operator()(const f32x4 (&acc)[2][2][4][2], const Unit& u, int wr, int wc, int fr, int fq) const {
        if (u.kind == 0) return g(acc, u, wr, wc, fr, fq);
        return r(acc, u, wr, wc, fr, fq);
    }
};
struct EpiOut {
    const float* x; bf16_t* pre;
    __device__ __forceinline__ bool operator()(const f32x4 (&acc)[2][2][4][2], const Unit& u, int wr, int wc, int fr, int fq) const {
        const int row0 = u.pm * BM + wr * 64 + fr, col0 = u.pn * 256 + wc * 32 + 8 * fq;
#pragma unroll
        for (int ai = 0; ai < 2; ++ai)
#pragma unroll
            for (int m = 0; m < 4; ++m) { const size_t off = (size_t)(row0 + ai * HALF + m * 16) * 1024 + col0;
#pragma unroll
                for (int bj = 0; bj < 2; ++bj) {
                    const f32x4 v0 = acc[ai][bj][m][0] + *(const f32x4*)(x + off + bj * HALF), v1 = acc[ai][bj][m][1] + *(const f32x4*)(x + off + bj * HALF + 4);
                    u32x4 w; w.x = cvt_pk_bf16(v0[0], v0[1]); w.y = cvt_pk_bf16(v0[2], v0[3]); w.z = cvt_pk_bf16(v1[0], v1[1]); w.w = cvt_pk_bf16(v1[2], v1[3]);
                    *(u32x4*)(pre + off + bj * HALF) = w; } }
        return false;
    }
};
}

struct Args {
    const float* x; const float* norm_g; const float* w_in; const float* w_dec_up; const float* b_dec; const float* gla_norm_g;
    const float* w_pa; const float* w_pb; const float* b_gate; const float* w_o; const float* final_g;
    float* out; unsigned char* ws;
};

__device__ __forceinline__ void p0_transpose_item(const float* W, int K, int ld, int nblk, bf16_t* WT, int row_off, LAS float* scr, int item, int lane) {
    const int kb = item / nblk, nb = item % nblk, k0 = 64 * kb, n0 = 32 * nb;
    float tv[32];
#pragma unroll
    for (int i = 0; i < 32; ++i) tv[i] = W[(size_t)(k0 + 2 * i + (lane >> 5)) * ld + n0 + (lane & 31)];
#pragma unroll
    for (int i = 0; i < 32; ++i) scr[(2 * i + (lane >> 5)) * 33 + (lane & 31)] = tv[i];
    LDS_WAIT(); asm volatile("" ::: "memory");
    const int c = lane & 7;
#pragma unroll
    for (int j = 0; j < 4; ++j) { const int n = (lane >> 3) + 8 * j; const LAS float* s = scr + (8 * c) * 33 + n;
        u32x4 o; o.x = pk2(s[0 * 33], s[1 * 33]); o.y = pk2(s[2 * 33], s[3 * 33]); o.z = pk2(s[4 * 33], s[5 * 33]); o.w = pk2(s[6 * 33], s[7 * 33]);
        *(u32x4*)(WT + (size_t)(row_off + n0 + n) * K + k0 + 8 * c) = o; }
    LDS_WAIT(); asm volatile("" ::: "memory");
}

__device__ __forceinline__ void p0_prologue(const Args& a, LAS unsigned char* lds, int gw, int NGW, int wave, int lane, int tid) {
    bf16_t* WIN = (bf16_t*)(a.ws + WS_WIN); bf16_t* WPAB = (bf16_t*)(a.ws + WS_WPAB); bf16_t* WO = (bf16_t*)(a.ws + WS_WO);
    float* grank = (float*)(a.ws + WS_RANK);
    bf16_t* H = (bf16_t*)a.out;
    LAS float* scr = (LAS float*)(lds + wave * 16384);
    constexpr int I1 = 16 * 96, I2 = 16 * 192, I3 = 16 * 32;
    constexpr int NITEMS = I1 + I2 + 3 * I3;
    for (int it = gw; it < NITEMS; it += NGW) {
        int r = it;
        if (r < I1) { p0_transpose_item(a.w_in, 1024, IN_COLS, 96, WIN, 0, scr, r, lane); continue; } r -= I1;
        if (r < I2) { p0_transpose_item(a.w_in + 3088, 1024, IN_COLS, 192, WIN, 3072, scr, r, lane); continue; } r -= I2;
        if (r < I3) { p0_transpose_item(a.w_pa, 1024, 1024, 32, WPAB, 0, scr, r, lane); continue; } r -= I3;
        if (r < I3) { p0_transpose_item(a.w_pb, 1024, 1024, 32, WPAB, 1024, scr, r, lane); continue; } r -= I3;
        p0_transpose_item(a.w_o, 1024, 1024, 32, WO, 0, scr, r, lane);
    }
    __syncthreads();
    LAS float* wrt = (LAS float*)lds;
    for (int e = tid; e < 1024 * 16; e += NTHREADS) { const int k = e >> 4, r = e & 15; wrt[r * 1024 + k] = a.w_in[(size_t)k * IN_COLS + RANK_OFF + r]; }
    __syncthreads();
    f32x4 nv[4];
    { const f32x4* xr0 = (const f32x4*)(a.x + (size_t)gw * D) + lane;
#pragma unroll
      for (int j = 0; j < 4; ++j) nv[j] = xr0[64 * j]; }
    for (int m = gw; m < M; m += NGW) {
        const f32x4* gr = (const f32x4*)a.norm_g + lane;
        f32x4 v[4]; float s2 = 0.f;
#pragma unroll
        for (int j = 0; j < 4; ++j) { v[j] = nv[j]; s2 += (v[j].x * v[j].x + v[j].y * v[j].y) + (v[j].z * v[j].z + v[j].w * v[j].w); }
        if (m + NGW < M) { const f32x4* xn = (const f32x4*)(a.x + (size_t)(m + NGW) * D) + lane;
#pragma unroll
            for (int j = 0; j < 4; ++j) nv[j] = xn[64 * j]; }
        const float rstd = 1.f / sqrtf(wave_sum(s2) * (1.f / D) + EPS);
#pragma unroll
        for (int j = 0; j < 4; ++j) v[j] = v[j] * rstd * gr[64 * j];
        unsigned long long* o8 = (unsigned long long*)(H + (size_t)m * D) + lane;
#pragma unroll
        for (int j = 0; j < 4; ++j) o8[64 * j] = (unsigned long long)pk2(v[j].x, v[j].y) | ((unsigned long long)pk2(v[j].z, v[j].w) << 32);
        float acc16[16];
#pragma unroll
        for (int r = 0; r < 16; ++r) { float p = 0.f;
#pragma unroll
            for (int j = 0; j < 4; ++j) { const f32x4 w = *(const LAS f32x4*)(wrt + r * 1024 + 256 * j + 4 * lane); p += (v[j].x * w.x + v[j].y * w.y) + (v[j].z * w.z + v[j].w * w.w); }
            acc16[r] = p; __builtin_amdgcn_sched_barrier(0); }
        float a8[8], a4[4], a2[2];
#pragma unroll
        for (int r = 0; r < 8; ++r) { const bool up = (lane & 32) != 0; const float send = up ? acc16[r] : acc16[r + 8], keep = up ? acc16[r + 8] : acc16[r]; a8[r] = keep + __shfl_xor(send, 32); }
#pragma unroll
        for (int r = 0; r < 4; ++r) { const bool up = (lane & 16) != 0; const float send = up ? a8[r] : a8[r + 4], keep = up ? a8[r + 4] : a8[r]; a4[r] = keep + __shfl_xor(send, 16); }
#pragma unroll
        for (int r = 0; r < 2; ++r) { const bool up = (lane & 8) != 0; const float send = up ? a4[r] : a4[r + 2], keep = up ? a4[r + 2] : a4[r]; a2[r] = keep + __shfl_xor(send, 8); }
        float a1; { const bool up = (lane & 4) != 0; const float send = up ? a2[0] : a2[1], keep = up ? a2[1] : a2[0]; a1 = keep + __shfl_xor(send, 4); }
        a1 += __shfl_xor(a1, 2); a1 += __shfl_xor(a1, 1);
        if ((lane & 3) == 0) { const int rk = ((lane >> 5) & 1) * 8 + ((lane >> 4) & 1) * 4 + ((lane >> 3) & 1) * 2 + ((lane >> 2) & 1); grank[(size_t)m * 16 + rk] = a1; }
    }
}

typedef float f32x16 __attribute__((ext_vector_type(16)));
typedef short v4i16_t __attribute__((ext_vector_type(4)));
typedef __bf16 bf16x2_t __attribute__((ext_vector_type(2)));
__device__ __forceinline__ unsigned cvtpk(float lo, float hi) { f32x2 v = {lo, hi}; bf16x2_t b = __builtin_convertvector(v, bf16x2_t); return __builtin_bit_cast(unsigned, b); }
__device__ __forceinline__ v4i16_t vtr(LAS unsigned char* p) { return __builtin_amdgcn_ds_read_tr16_b64_v4i16((LAS v4i16_t*)p); }
__device__ __forceinline__ void sb_mfma(const Args& a, LAS unsigned char* lds, int tid, int lane, int wave) {
    const bf16_t* SQ = (const bf16_t*)(a.ws + WS_ACT + B_SQ * ACT_STRIDE); const bf16_t* SK = (const bf16_t*)(a.ws + WS_ACT + B_SK * ACT_STRIDE);
    const bf16_t* SV = (const bf16_t*)(a.ws + WS_ACT + B_SV * ACT_STRIDE); bf16_t* SG = (bf16_t*)(a.ws + WS_ACT + B_SG * ACT_STRIDE);
    constexpr int RS = 272;
    LAS unsigned char* Kl = lds; LAS unsigned char* Vl = lds + 64 * RS;
    const int h = lane >> 5, r32 = lane & 31, i16 = lane & 15, tq = i16 >> 2, tp = i16 & 3, blk = (lane >> 4) & 1;
    const int lrow = tid >> 3, lseg = tid & 7;
    const float C2 = 0.08838834764831845f * 1.4426950408889634f;
    for (int pi = blockIdx.x; pi < 256; pi += gridDim.x) {
#pragma unroll 1
        for (int half = 0; half < 2; ++half) {
            const int ps = (pi & 7) * 32 + (pi >> 3);
            const int bh = ps >> 2, qb = half == 0 ? (ps & 3) : 7 - (ps & 3), b = bh >> 3, hh = bh & 7;
            const int q0 = 256 * qb + 32 * wave;
            bf16x8 qf[8];
            { const bf16_t* qp = SQ + ((size_t)b * SEQ + q0 + r32) * 1024 + hh * 128 + 8 * h;
#pragma unroll
              for (int s = 0; s < 8; ++s) qf[s] = *(const bf16x8*)(qp + 16 * s); }
            f32x16 o[4];
#pragma unroll
            for (int d = 0; d < 4; ++d)
#pragma unroll
                for (int i = 0; i < 16; ++i) o[d][i] = 0.f;
            float R = 0.f; int wdone = 0;
            LAS int* donef = (LAS int*)(lds + 2 * 64 * RS);
            __syncthreads();
            if (lane == 0) donef[wave] = 0;
            const int nkt = 4 * qb + 4;
            const bf16_t* kbase = SK + ((size_t)b * SEQ + lrow) * 1024 + hh * 128 + lseg * 16;
            const bf16_t* vbase = SV + ((size_t)b * SEQ + lrow) * 1024 + hh * 128 + lseg * 16;
            u32x4 kr0, kr1, vr0, vr1;
            { const size_t off = (size_t)(nkt - 1) * 64 * 1024; kr0 = *(const u32x4*)(kbase + off); kr1 = *(const u32x4*)(kbase + off + 8); vr0 = *(const u32x4*)(vbase + off); vr1 = *(const u32x4*)(vbase + off + 8); }
#pragma unroll 1
            for (int kt = nkt - 1; kt >= 0; --kt) {
                __syncthreads();
                if ((donef[0] & donef[1] & donef[2] & donef[3] & donef[4] & donef[5] & donef[6] & donef[7]) != 0) break;
                *(LAS u32x4*)(Kl + lrow * RS + lseg * 32) = kr0; *(LAS u32x4*)(Kl + lrow * RS + lseg * 32 + 16) = kr1;
                *(LAS u32x4*)(Vl + lrow * RS + lseg * 32) = vr0; *(LAS u32x4*)(Vl + lrow * RS + lseg * 32 + 16) = vr1;
                __syncthreads();
                if (kt > 0) { const size_t off = (size_t)(kt - 1) * 64 * 1024; kr0 = *(const u32x4*)(kbase + off); kr1 = *(const u32x4*)(kbase + off + 8); vr0 = *(const u32x4*)(vbase + off); vr1 = *(const u32x4*)(vbase + off + 8); }
                if (64 * kt <= q0 + 30 && !wdone) {
#pragma unroll 1
                    for (int st = 1; st >= 0; --st) {
                        f32x16 z;
#pragma unroll
                        for (int i = 0; i < 16; ++i) z[i] = 0.f;
#pragma unroll
                        for (int s = 0; s < 8; ++s) { const bf16x8 kf = *(const LAS bf16x8*)(Kl + (32 * st + r32) * RS + (16 * s + 8 * h) * 2); z = __builtin_amdgcn_mfma_f32_32x32x16_bf16(kf, qf[s], z, 0, 0, 0); }
                        const int kabs0 = 64 * kt + 32 * st + 4 * h, qabs = q0 + r32; const bool full = (64 * kt + 64 <= q0);
                        float ls[16], lm[16];
                        if (full) {
#pragma unroll
                            for (int i = 0; i < 16; ++i) { const float z2 = z[i] * C2; const float e = __builtin_amdgcn_exp2f(-fabsf(z2)); const float l2 = __builtin_amdgcn_logf(1.f + e);
                                const float l = fminf(z2, 0.f) - l2; ls[i] = l; lm[i] = l - z2; }
                        } else {
#pragma unroll
                            for (int i = 0; i < 16; ++i) { const float z2 = z[i] * C2; const float e = __builtin_amdgcn_exp2f(-fabsf(z2)); const float l2 = __builtin_amdgcn_logf(1.f + e);
                                const float l = fminf(z2, 0.f) - l2; const bool valid = (kabs0 + (i & 3) + 8 * (i >> 2)) < qabs; ls[i] = valid ? l : -1e30f; lm[i] = valid ? (l - z2) : 0.f; }
                        }
                        float To[4], Tp[4], G[4];
#pragma unroll
                        for (int g = 0; g < 4; ++g) To[g] = (lm[4 * g] + lm[4 * g + 1]) + (lm[4 * g + 2] + lm[4 * g + 3]);
#pragma unroll
                        for (int g = 0; g < 4; ++g) Tp[g] = __shfl_xor(To[g], 32);
                        G[3] = 0.f; G[2] = To[3] + Tp[3]; G[1] = G[2] + (To[2] + Tp[2]); G[0] = G[1] + (To[1] + Tp[1]);
                        const float total = G[0] + (To[0] + Tp[0]);
                        float A[16];
#pragma unroll
                        for (int g = 0; g < 4; ++g) { const float base = R + G[g] + (h == 0 ? Tp[g] : 0.f);
                            const float c3 = base, c2 = c3 + lm[4 * g + 3], c1 = c2 + lm[4 * g + 2], c0 = c1 + lm[4 * g + 1];
                            A[4 * g + 3] = __builtin_amdgcn_exp2f(ls[4 * g + 3] + c3); A[4 * g + 2] = __builtin_amdgcn_exp2f(ls[4 * g + 2] + c2);
                            A[4 * g + 1] = __builtin_amdgcn_exp2f(ls[4 * g + 1] + c1); A[4 * g] = __builtin_amdgcn_exp2f(ls[4 * g] + c0); }
                        R += total;
                        { const int alld = __all(R < -151.f) ? 1 : 0; if (st == 0) { wdone = alld; if (lane == 0) donef[wave] = alld; } }
                        u32x4 p0, p1;
                        p0.x = cvtpk(A[0], A[1]); p0.y = cvtpk(A[2], A[3]); p0.z = cvtpk(A[4], A[5]); p0.w = cvtpk(A[6], A[7]);
                        p1.x = cvtpk(A[8], A[9]); p1.y = cvtpk(A[10], A[11]); p1.z = cvtpk(A[12], A[13]); p1.w = cvtpk(A[14], A[15]);
                        const bf16x8 pa0 = __builtin_bit_cast(bf16x8, p0), pa1 = __builtin_bit_cast(bf16x8, p1);
                        LAS unsigned char* vp = Vl + (32 * st + 4 * h + tq) * RS + (16 * blk + 4 * tp) * 2;
#pragma unroll
                        for (int d = 0; d < 4; ++d) {
                            const v4i16_t a0 = vtr(vp + d * 64), a1 = vtr(vp + 8 * RS + d * 64), b0 = vtr(vp + 16 * RS + d * 64), b1 = vtr(vp + 24 * RS + d * 64);
                            const bf16x8 vb0 = __builtin_shufflevector(a0, a1, 0, 1, 2, 3, 4, 5, 6, 7), vb1 = __builtin_shufflevector(b0, b1, 0, 1, 2, 3, 4, 5, 6, 7);
                            o[d] = __builtin_amdgcn_mfma_f32_32x32x16_bf16(pa0, vb0, o[d], 0, 0, 0);
                            o[d] = __builtin_amdgcn_mfma_f32_32x32x16_bf16(pa1, vb1, o[d], 0, 0, 0); }
                    }
                }
            }
            bf16_t* gp0 = SG + ((size_t)b * SEQ + q0 + 4 * h) * 1024 + hh * 128 + r32;
#pragma unroll
            for (int d = 0; d < 4; ++d) {
#pragma unroll
                for (int i = 0; i < 16; ++i) { bf16_t* gp = gp0 + ((i & 3) + 8 * (i >> 2)) * 1024 + 32 * d;
                    *gp = (bf16_t)f2bf(o[d][i] * bf2f(*gp)); }
                __builtin_amdgcn_sched_barrier(0); }
        }
    }
}

__device__ __forceinline__ bf16x8 cat44(v4i16_t lo, v4i16_t hi) { return __builtin_shufflevector(lo, hi, 0, 1, 2, 3, 4, 5, 6, 7); }
constexpr size_t WS_DL = 26 * MiB;
__device__ __forceinline__ void gla_pre(const Args& a, LAS unsigned char* lds, int item, int tid, int lane, int wave) {
    bf16_t* GQK = (bf16_t*)(a.ws + WS_ACT + B_GQK * ACT_STRIDE); const float* grank = (const float*)(a.ws + WS_RANK);
    bf16_t* ATT = (bf16_t*)a.out + (size_t)M * 1024 + (size_t)item * 4096; float* DLg = (float*)(a.ws + WS_DL) + (size_t)item * 128;
    constexpr int RS = 272;
    LAS unsigned char* QE = lds; LAS unsigned char* KE = QE + 64 * RS; LAS unsigned char* KD = KE + 64 * RS; LAS float* GR = (LAS float*)(KD + 64 * RS); LAS float* TOT = GR + 64 * 16;
    const int b = item >> 7, hd = (item >> 5) & 3, ch = item & 31;
    const int h = lane >> 5, r32 = lane & 31;
    const int pd = tid & 127, jg = tid >> 7;
    const size_t rowb = (size_t)b * SEQ + 64 * ch;
    float wu[16];
#pragma unroll
    for (int r = 0; r < 16; ++r) wu[r] = a.w_dec_up[r * 512 + hd * 128 + pd];
    const float bd = a.b_dec[hd * 128 + pd];
    if (tid < 256) *(LAS f32x4*)(GR + tid * 4) = *(const f32x4*)(grank + rowb * 16 + tid * 4);
    { const int row = tid >> 3, seg = tid & 7; const bf16_t* gq = GQK + (rowb + row) * 1024 + hd * 128 + seg * 16;
      LAS u32x4* dq = (LAS u32x4*)(QE + row * RS + seg * 32); LAS u32x4* dk = (LAS u32x4*)(KD + row * RS + seg * 32);
      dq[0] = ((const u32x4*)gq)[0]; dq[1] = ((const u32x4*)gq)[1]; dk[0] = ((const u32x4*)(gq + 512))[0]; dk[1] = ((const u32x4*)(gq + 512))[1]; }
    __syncthreads();
    float cum[16];
    { float run = 0.f;
#pragma unroll
      for (int u = 0; u < 16; ++u) { const LAS f32x4* g4 = (const LAS f32x4*)(GR + (16 * jg + u) * 16); float z = bd;
#pragma unroll
          for (int r4 = 0; r4 < 4; ++r4) { const f32x4 g = g4[r4]; z += g.x * wu[4 * r4] + g.y * wu[4 * r4 + 1] + g.z * wu[4 * r4 + 2] + g.w * wu[4 * r4 + 3]; }
          const float la = (fminf(z, 0.f) - __logf(1.f + __expf(-fabsf(z)))) * (1.f / 16.f); run += la; cum[u] = run; }
      TOT[jg * 128 + pd] = run; }
    __syncthreads();
    { const float t0s = TOT[pd], t1s = TOT[128 + pd], t2s = TOT[256 + pd], t3s = TOT[384 + pd];
      const float off = jg == 0 ? 0.f : (jg == 1 ? t0s : (jg == 2 ? t0s + t1s : t0s + t1s + t2s)); const float blast = (t0s + t1s) + (t2s + t3s);
      const float dlv = __expf(blast);
      if (jg == 0) DLg[pd] = dlv;
#pragma unroll
      for (int u = 0; u < 16; ++u) { const float bc = off + cum[u]; const int t = 16 * jg + u;
          const float q = bf2f(*(const LAS bf16_t*)(QE + t * RS + pd * 2)), k = bf2f(*(const LAS bf16_t*)(KD + t * RS + pd * 2));
          const float eb = __expf(bc), ke = k * __builtin_amdgcn_rcpf(eb);
          *(LAS bf16_t*)(QE + t * RS + pd * 2) = (bf16_t)f2bf(q * eb * 0.08838834764831845f);
          *(LAS bf16_t*)(KE + t * RS + pd * 2) = (bf16_t)f2bf(ke);
          *(LAS bf16_t*)(KD + t * RS + pd * 2) = (bf16_t)f2bf(ke * dlv); } }
    __syncthreads();
    if (wave < 3) { const int it = wave == 0 ? 0 : 1, jt = wave == 2 ? 1 : 0;
        f32x16 z;
#pragma unroll
        for (int i = 0; i < 16; ++i) z[i] = 0.f;
#pragma unroll
        for (int s = 0; s < 8; ++s) { const bf16x8 af = *(const LAS bf16x8*)(QE + (32 * it + r32) * RS + (16 * s + 8 * h) * 2), bfr = *(const LAS bf16x8*)(KE + (32 * jt + r32) * RS + (16 * s + 8 * h) * 2);
            z = __builtin_amdgcn_mfma_f32_32x32x16_bf16(af, bfr, z, 0, 0, 0); }
#pragma unroll
        for (int i = 0; i < 16; ++i) { const int ir = 32 * it + (i & 3) + 8 * (i >> 2) + 4 * h, jc = 32 * jt + r32;
            ATT[ir * 64 + jc] = (bf16_t)f2bf(jc <= ir ? z[i] : 0.f); } }
    { const int row = tid >> 3, seg = tid & 7; bf16_t* gq = GQK + (rowb + row) * 1024 + hd * 128 + seg * 16;
      const LAS u32x4* sq = (const LAS u32x4*)(QE + row * RS + seg * 32); const LAS u32x4* sk = (const LAS u32x4*)(KD + row * RS + seg * 32);
      ((u32x4*)gq)[0] = sq[0]; ((u32x4*)gq)[1] = sq[1]; ((u32x4*)(gq + 512))[0] = sk[0]; ((u32x4*)(gq + 512))[1] = sk[1]; }
    __syncthreads();
}
constexpr size_t WS_SA = 27 * MiB;
constexpr size_t WS_DCUM = 31 * MiB;
__device__ __forceinline__ void gla_norm_store(LAS unsigned char* OB, LAS float* NG, bf16_t* GG, size_t rowp, int hd, int tid, u32x4 rg0, u32x4 rg1, u32x4 rg2, u32x4 rg3) {
    constexpr int VS = 528;
    const int row = tid >> 3, part = tid & 7; const LAS u32x4* src = (const LAS u32x4*)(OB + row * VS + part * 64);
    u32x4 w[4]; float ss = 0.f;
#pragma unroll
    for (int c = 0; c < 4; ++c) { w[c] = src[c]; const float e0 = bflo(w[c].x), e1 = bfhi(w[c].x), e2 = bflo(w[c].y), e3 = bfhi(w[c].y), e4 = bflo(w[c].z), e5 = bfhi(w[c].z), e6 = bflo(w[c].w), e7 = bfhi(w[c].w);
        ss += (e0 * e0 + e1 * e1) + (e2 * e2 + e3 * e3) + (e4 * e4 + e5 * e5) + (e6 * e6 + e7 * e7); }
    ss += __shfl_xor(ss, 1); ss += __shfl_xor(ss, 2); ss += __shfl_xor(ss, 4);
    const float rstd = 1.f / sqrtf(ss * (1.f / 256.f) + EPS);
    u32x4* gp = (u32x4*)(GG + (rowp + row) * 1024 + hd * 256 + part * 32); const LAS f32x4* ng = (const LAS f32x4*)(NG + part * 32);
#pragma unroll
    for (int c = 0; c < 4; ++c) { const u32x4 gt = c == 0 ? rg0 : (c == 1 ? rg1 : (c == 2 ? rg2 : rg3)); const f32x4 n0 = ng[2 * c], n1 = ng[2 * c + 1]; u32x4 r;
        r.x = pk2(bflo(w[c].x) * rstd * n0.x * bflo(gt.x), bfhi(w[c].x) * rstd * n0.y * bfhi(gt.x)); r.y = pk2(bflo(w[c].y) * rstd * n0.z * bflo(gt.y), bfhi(w[c].y) * rstd * n0.w * bfhi(gt.y));
        r.z = pk2(bflo(w[c].z) * rstd * n1.x * bflo(gt.z), bfhi(w[c].z) * rstd * n1.y * bfhi(gt.z)); r.w = pk2(bflo(w[c].w) * rstd * n1.z * bflo(gt.w), bfhi(w[c].w) * rstd * n1.w * bfhi(gt.w));
        gp[c] = r; }
}
__device__ __forceinline__ void gla_raw_store(LAS unsigned char* OB, bf16_t* GV, size_t rowp, int hd, int tid) {
    constexpr int VS = 528;
    const int row = tid >> 3, part = tid & 7; const LAS u32x4* src = (const LAS u32x4*)(OB + row * VS + part * 64);
    u32x4* gp = (u32x4*)(GV + (rowp + row) * 1024 + hd * 256 + part * 32);
    gp[0] = src[0]; gp[1] = src[1]; gp[2] = src[2]; gp[3] = src[3];
}
template <int half> __device__ __forceinline__ void gla_serial(const Args& a, LAS unsigned char* lds, int item, int tid, int lane, int wave) {
    const bf16_t* GQK = (const bf16_t*)(a.ws + WS_ACT + B_GQK * ACT_STRIDE); bf16_t* GV = (bf16_t*)(a.ws + WS_ACT + B_GV * ACT_STRIDE);
    bf16_t* GG = (bf16_t*)(a.ws + WS_ACT + B_GG * ACT_STRIDE);
    const bf16_t* ATT = (const bf16_t*)a.out + (size_t)M * 1024 + (size_t)item * 32 * 4096; const float* DLg = (const float*)(a.ws + WS_DL) + (size_t)item * 32 * 128;
    float* DCUM = (float*)(a.ws + WS_DCUM) + (size_t)item * 16 * 128;
    constexpr int RS = 272, VS = 528, AS = 144;
    LAS unsigned char* QE = lds; LAS unsigned char* KD = QE + 64 * RS; LAS unsigned char* VL = KD + 64 * RS; LAS unsigned char* AT = VL + 64 * VS; LAS float* DL = (LAS float*)(AT + 64 * AS); LAS unsigned char* OB = (LAS unsigned char*)(DL + 128); LAS float* NG = (LAS float*)(OB + 64 * VS);
    const int b = item >> 2, hd = item & 3, c0 = 16 * half;
    const int h = lane >> 5, r32 = lane & 31, i16 = lane & 15, tq = i16 >> 2, tp = i16 & 3, blk = (lane >> 4) & 1;
    const int lrow = tid >> 3, lseg = tid & 7;
    f32x16 S[4];
#pragma unroll
    for (int d = 0; d < 4; ++d)
#pragma unroll
        for (int i = 0; i < 16; ++i) S[d][i] = 0.f;
    u32x4 rq0, rq1, rk0, rk1, rv0, rv1, rv2, rv3, ra, rg0, rg1, rg2, rg3; f32x4 rd = {0.f, 0.f, 0.f, 0.f};
    float dcum = 1.f;
    if (tid < 64) *(LAS f32x4*)(NG + tid * 4) = *(const f32x4*)(a.gla_norm_g + tid * 4);
    rg0 = rg1 = rg2 = rg3 = (u32x4){0u, 0u, 0u, 0u};
#define GLA_FETCH(ch) do { const size_t rowg = (size_t)b * SEQ + 64 * (ch) + lrow; const u32x4* pq = (const u32x4*)(GQK + rowg * 1024 + hd * 128 + lseg * 16); \
        rq0 = pq[0]; rq1 = pq[1]; const u32x4* pk = (const u32x4*)(GQK + rowg * 1024 + 512 + hd * 128 + lseg * 16); rk0 = pk[0]; rk1 = pk[1]; \
        const u32x4* pv = (const u32x4*)(GV + rowg * 1024 + hd * 256 + lseg * 32); rv0 = pv[0]; rv1 = pv[1]; rv2 = pv[2]; rv3 = pv[3]; \
        ra = *(const u32x4*)(ATT + (size_t)(ch) * 4096 + lrow * 64 + lseg * 8); if (tid < 32) rd = *(const f32x4*)(DLg + (size_t)(ch) * 128 + tid * 4); } while (0)
#define GLA_GATE(ch) do { const u32x4* pg = (const u32x4*)(GG + ((size_t)b * SEQ + 64 * (ch) + lrow) * 1024 + hd * 256 + lseg * 32); rg0 = pg[0]; rg1 = pg[1]; rg2 = pg[2]; rg3 = pg[3]; } while (0)
    GLA_FETCH(c0);
#pragma unroll 1
    for (int ch = c0; ch < c0 + 16; ++ch) {
        const size_t rowb = (size_t)b * SEQ + 64 * ch;
        __syncthreads();
        { LAS u32x4* dq = (LAS u32x4*)(QE + lrow * RS + lseg * 32); dq[0] = rq0; dq[1] = rq1; LAS u32x4* dk = (LAS u32x4*)(KD + lrow * RS + lseg * 32); dk[0] = rk0; dk[1] = rk1;
          LAS u32x4* dv = (LAS u32x4*)(VL + lrow * VS + lseg * 64); dv[0] = rv0; dv[1] = rv1; dv[2] = rv2; dv[3] = rv3;
          *(LAS u32x4*)(AT + lrow * AS + lseg * 16) = ra; if (tid < 32) *(LAS f32x4*)(DL + tid * 4) = rd; }
        if (ch > c0) { if constexpr (half == 0) gla_norm_store(OB, NG, GG, rowb - 64, hd, tid, rg0, rg1, rg2, rg3); else gla_raw_store(OB, GV, rowb - 64, hd, tid); }
        __syncthreads();
        if (ch + 1 < c0 + 16) GLA_FETCH(ch + 1);
        if constexpr (half == 0) { GLA_GATE(ch); }
        else { if (tid < 128) { DCUM[(ch - 16) * 128 + tid] = dcum; dcum *= DL[tid]; } }
        bf16x8 vf[4];
        { LAS unsigned char* vp = VL + (8 * h + tq) * VS + (32 * wave + 16 * blk + 4 * tp) * 2;
#pragma unroll
          for (int s = 0; s < 4; ++s) vf[s] = cat44(vtr(vp + 16 * s * VS), vtr(vp + (16 * s + 4) * VS)); }
        f32x16 o[2];
#pragma unroll
        for (int it = 0; it < 2; ++it) {
#pragma unroll
            for (int i = 0; i < 16; ++i) o[it][i] = 0.f;
#pragma unroll
            for (int s = 0; s < 4; ++s) if (s < 2 * (it + 1)) { const bf16x8 af = *(const LAS bf16x8*)(AT + (32 * it + r32) * AS + (16 * s + 8 * h) * 2); o[it] = __builtin_amdgcn_mfma_f32_32x32x16_bf16(af, vf[s], o[it], 0, 0, 0); }
        }
#pragma unroll
        for (int dt = 0; dt < 4; ++dt)
#pragma unroll
            for (int s = 0; s < 2; ++s) { u32x4 p; p.x = cvtpk(S[dt][8 * s], S[dt][8 * s + 1]); p.y = cvtpk(S[dt][8 * s + 2], S[dt][8 * s + 3]); p.z = cvtpk(S[dt][8 * s + 4], S[dt][8 * s + 5]); p.w = cvtpk(S[dt][8 * s + 6], S[dt][8 * s + 7]);
                const bf16x8 sb = __builtin_bit_cast(bf16x8, p);
#pragma unroll
                for (int it = 0; it < 2; ++it) { LAS unsigned char* qa = QE + (32 * it + r32) * RS + (32 * dt + 16 * s + 4 * h) * 2;
                    const v4i16_t lo = *(const LAS v4i16_t*)qa, hi = *(const LAS v4i16_t*)(qa + 16);
                    o[it] = __builtin_amdgcn_mfma_f32_32x32x16_bf16(cat44(lo, hi), sb, o[it], 0, 0, 0); } }
#pragma unroll
        for (int dt = 0; dt < 4; ++dt) {
#pragma unroll
            for (int g = 0; g < 4; ++g) { const f32x4 dl4 = *(const LAS f32x4*)(DL + 32 * dt + 8 * g + 4 * h); S[dt][4 * g] *= dl4.x; S[dt][4 * g + 1] *= dl4.y; S[dt][4 * g + 2] *= dl4.z; S[dt][4 * g + 3] *= dl4.w; }
            LAS unsigned char* kp = KD + (8 * h + tq) * RS + (32 * dt + 16 * blk + 4 * tp) * 2;
#pragma unroll
            for (int s = 0; s < 4; ++s) { const bf16x8 af = cat44(vtr(kp + 16 * s * RS), vtr(kp + (16 * s + 4) * RS)); S[dt] = __builtin_amdgcn_mfma_f32_32x32x16_bf16(af, vf[s], S[dt], 0, 0, 0); } }
#pragma unroll
        for (int it = 0; it < 2; ++it)
#pragma unroll
            for (int i = 0; i < 16; ++i) *(LAS bf16_t*)(OB + (32 * it + (i & 3) + 8 * (i >> 2) + 4 * h) * VS + (32 * wave + r32) * 2) = (bf16_t)f2bf(o[it][i]);
    }
    __syncthreads();
    { const size_t rowp = (size_t)b * SEQ + 64 * (c0 + 15);
      if constexpr (half == 0) gla_norm_store(OB, NG, GG, rowp, hd, tid, rg0, rg1, rg2, rg3); else gla_raw_store(OB, GV, rowp, hd, tid); }
    if constexpr (half == 0) { unsigned* SAp = (unsigned*)(a.ws + WS_SA) + ((size_t)item * 8 + wave) * 2048;
#pragma unroll
        for (int dt = 0; dt < 4; ++dt)
#pragma unroll
            for (int j = 0; j < 8; ++j) SAp[(dt * 8 + j) * 64 + lane] = cvtpk(S[dt][2 * j], S[dt][2 * j + 1]); }
#undef GLA_FETCH
#undef GLA_GATE
}
__device__ __forceinline__ void gla_fix(const Args& a, LAS unsigned char* lds, int pitem, int tid, int lane, int wave) {
    const bf16_t* GQK = (const bf16_t*)(a.ws + WS_ACT + B_GQK * ACT_STRIDE); const bf16_t* GV = (const bf16_t*)(a.ws + WS_ACT + B_GV * ACT_STRIDE);
    bf16_t* GG = (bf16_t*)(a.ws + WS_ACT + B_GG * ACT_STRIDE);
    constexpr int RS = 272, VS = 528;
    LAS unsigned char* QE = lds; LAS unsigned char* OB = QE + 64 * RS; LAS float* DL = (LAS float*)(OB + 64 * VS); LAS float* NG = DL + 128;
    const int psw = (pitem & 7) * 32 + (pitem >> 3);
    const int item = psw >> 3, b = item >> 2, hd = item & 3;
    const int h = lane >> 5, r32 = lane & 31, lrow = tid >> 3, lseg = tid & 7;
    unsigned Sp[4][8];
    { const unsigned* SAp = (const unsigned*)(a.ws + WS_SA) + ((size_t)item * 8 + wave) * 2048;
#pragma unroll
      for (int dt = 0; dt < 4; ++dt)
#pragma unroll
          for (int j = 0; j < 8; ++j) Sp[dt][j] = SAp[(dt * 8 + j) * 64 + lane]; }
    if (tid < 64) *(LAS f32x4*)(NG + tid * 4) = *(const f32x4*)(a.gla_norm_g + tid * 4);
#pragma unroll 1
    for (int k = 0; k < 2; ++k) {
        const int cc = 2 * (psw & 7) + k;
        const size_t rowb = (size_t)b * SEQ + 64 * (16 + cc);
        { const u32x4* pq = (const u32x4*)(GQK + (rowb + lrow) * 1024 + hd * 128 + lseg * 16); LAS u32x4* dq = (LAS u32x4*)(QE + lrow * RS + lseg * 32); dq[0] = pq[0]; dq[1] = pq[1];
          const u32x4* po = (const u32x4*)(GV + (rowb + lrow) * 1024 + hd * 256 + lseg * 32); LAS u32x4* dob = (LAS u32x4*)(OB + lrow * VS + lseg * 64); dob[0] = po[0]; dob[1] = po[1]; dob[2] = po[2]; dob[3] = po[3];
          if (tid < 32) *(LAS f32x4*)(DL + tid * 4) = *(const f32x4*)((const float*)(a.ws + WS_DCUM) + ((size_t)item * 16 + cc) * 128 + tid * 4); }
        const u32x4* pg = (const u32x4*)(GG + (rowb + lrow) * 1024 + hd * 256 + lseg * 32); const u32x4 rg0 = pg[0], rg1 = pg[1], rg2 = pg[2], rg3 = pg[3];
        __syncthreads();
        f32x16 o[2];
#pragma unroll
        for (int it = 0; it < 2; ++it)
#pragma unroll
            for (int i = 0; i < 16; ++i) o[it][i] = 0.f;
#pragma unroll
        for (int dt = 0; dt < 4; ++dt)
#pragma unroll
            for (int s2 = 0; s2 < 2; ++s2) { const f32x4 dA = *(const LAS f32x4*)(DL + 32 * dt + 16 * s2 + 4 * h), dB = *(const LAS f32x4*)(DL + 32 * dt + 16 * s2 + 8 + 4 * h);
                const unsigned w0 = Sp[dt][4 * s2], w1 = Sp[dt][4 * s2 + 1], w2 = Sp[dt][4 * s2 + 2], w3 = Sp[dt][4 * s2 + 3];
                u32x4 p; p.x = cvtpk(bflo(w0) * dA.x, bfhi(w0) * dA.y); p.y = cvtpk(bflo(w1) * dA.z, bfhi(w1) * dA.w);
                p.z = cvtpk(bflo(w2) * dB.x, bfhi(w2) * dB.y); p.w = cvtpk(bflo(w3) * dB.z, bfhi(w3) * dB.w);
                const bf16x8 sb = __builtin_bit_cast(bf16x8, p);
#pragma unroll
                for (int it = 0; it < 2; ++it) { LAS unsigned char* qa = QE + (32 * it + r32) * RS + (32 * dt + 16 * s2 + 4 * h) * 2;
                    const v4i16_t lo = *(const LAS v4i16_t*)qa, hi = *(const LAS v4i16_t*)(qa + 16);
                    o[it] = __builtin_amdgcn_mfma_f32_32x32x16_bf16(cat44(lo, hi), sb, o[it], 0, 0, 0); } }
#pragma unroll
        for (int it = 0; it < 2; ++it)
#pragma unroll
            for (int i = 0; i < 16; ++i) { LAS bf16_t* op = (LAS bf16_t*)(OB + (32 * it + (i & 3) + 8 * (i >> 2) + 4 * h) * VS + (32 * wave + r32) * 2); *op = (bf16_t)f2bf(o[it][i] + bf2f(*op)); }
        __syncthreads();
        gla_norm_store(OB, NG, GG, rowb, hd, tid, rg0, rg1, rg2, rg3);
        __syncthreads();
    }
}

__device__ __forceinline__ void final_norm(const Args& a, int gw, int NGW, int lane) {
    const bf16_t* PRE = (const bf16_t*)(a.ws + WS_ACT + B_GQK * ACT_STRIDE);
    const f32x4* g = (const f32x4*)a.final_g;
    const f32x4 g0 = g[2 * lane], g1 = g[2 * lane + 1], g2 = g[128 + 2 * lane], g3 = g[128 + 2 * lane + 1];
    u32x4 nw0, nw1; f32x4 nx0, nx1, nx2, nx3;
#define FN_LOAD(m_) do { const u32x4* pr = (const u32x4*)(PRE + (size_t)(m_) * D) + lane; const f32x4* xr = (const f32x4*)(a.x + (size_t)(m_) * D) + 2 * lane; \
        nw0 = pr[0]; nw1 = pr[64]; nx0 = xr[0]; nx1 = xr[1]; nx2 = xr[128]; nx3 = xr[129]; } while (0)
    if (gw < M) FN_LOAD(gw);
    for (int m = gw; m < M; m += NGW) {
        f32x4 v[4];
        v[0] = nx0 + (f32x4){bflo(nw0.x), bfhi(nw0.x), bflo(nw0.y), bfhi(nw0.y)}; v[1] = nx1 + (f32x4){bflo(nw0.z), bfhi(nw0.z), bflo(nw0.w), bfhi(nw0.w)};
        v[2] = nx2 + (f32x4){bflo(nw1.x), bfhi(nw1.x), bflo(nw1.y), bfhi(nw1.y)}; v[3] = nx3 + (f32x4){bflo(nw1.z), bfhi(nw1.z), bflo(nw1.w), bfhi(nw1.w)};
        if (m + NGW < M) FN_LOAD(m + NGW);
        float s2 = 0.f;
#pragma unroll
        for (int j = 0; j < 4; ++j) s2 += (v[j].x * v[j].x + v[j].y * v[j].y) + (v[j].z * v[j].z + v[j].w * v[j].w);
        const float rstd = 1.f / sqrtf(wave_sum(s2) * (1.f / D) + EPS);
        f32x4* o = (f32x4*)(a.out + (size_t)m * D) + 2 * lane;
        o[0] = v[0] * rstd * g0; o[1] = v[1] * rstd * g1; o[128] = v[2] * rstd * g2; o[129] = v[3] * rstd * g3;
    }
#undef FN_LOAD
}

#define XB_TMO      128
#define XB_XCNT(j)  (256  + 64 * (j))
#define XB_XSUB(j)  (1280 + 64 * (j))
#define XB_XGEN(j)  (2304 + 64 * (j))
#define XB_TOP      3328
#define XB_TOPGEN   3392
#define XCD_BAR_WORDS 3456
#define XB_SPIN_CAP (1u << 18)

__device__ __forceinline__ unsigned xb_ld(unsigned* p)              { return __hip_atomic_load(p, __ATOMIC_RELAXED, __HIP_MEMORY_SCOPE_AGENT); }
__device__ __forceinline__ unsigned xb_add(unsigned* p, unsigned v) { return __hip_atomic_fetch_add(p, v, __ATOMIC_RELAXED, __HIP_MEMORY_SCOPE_AGENT); }
__device__ __forceinline__ unsigned xb_xcc_id() { return (unsigned)__builtin_amdgcn_s_getreg((3 << 11) | 20) & 0xFu; }
#define XB_SPIN(cond, bar) do { unsigned _sp = 0; while (cond) { __builtin_amdgcn_s_sleep(1); \
    if ((++_sp & 255u) == 0u) { if (xb_ld(&(bar)[XB_TMO])) break; if (_sp > XB_SPIN_CAP) { atomicAdd(&(bar)[XB_TMO], 1u); break; } } } } while (0)

struct XcdBarrier {
    unsigned* bar; unsigned x;
    volatile LAS unsigned* st;
};

__device__ __forceinline__ XcdBarrier xcd_barrier_post(unsigned* bar, volatile LAS unsigned* st) {
    XcdBarrier b; b.bar = bar; b.x = xb_xcc_id(); b.st = st;
    if (threadIdx.x == 0) (void)xb_add(&bar[XB_XCNT(b.x)], 1u);
    return b;
}
__device__ __forceinline__ void xcd_barrier_complete(unsigned* bar, unsigned x, unsigned& nloc, unsigned& nx) {
    const unsigned G = gridDim.x * gridDim.y * gridDim.z;
    unsigned sum, cnt, mine, sp = 0u;
    for (;;) {
        sum = 0u; cnt = 0u; mine = 0u;
#pragma unroll
        for (unsigned j = 0; j < 16; ++j) { const unsigned c = xb_ld(&bar[XB_XCNT(j)]); sum += c; cnt += (c > 0u) ? 1u : 0u; mine = (j == x) ? c : mine; }
        if (sum == G) break;
        __builtin_amdgcn_s_sleep(1);
        if ((++sp & 255u) == 0u) { if (xb_ld(&bar[XB_TMO])) break; if (sp > XB_SPIN_CAP) { atomicAdd(&bar[XB_TMO], 1u); break; } }
    }
    nloc = mine > 0u ? mine : 1u; nx = cnt > 0u ? cnt : 1u;
}

__device__ __forceinline__ void xcd_barrier(const XcdBarrier& b) {
    asm volatile("s_waitcnt vmcnt(0)" ::: "memory");
    __syncthreads();
    if (threadIdx.x == 0) {
        unsigned* bar = b.bar;
        __builtin_amdgcn_s_waitcnt(0);
        unsigned nloc = b.st[0], nx = b.st[1];
        if (nloc == 0u) { xcd_barrier_complete(bar, b.x, nloc, nx); b.st[0] = nloc; b.st[1] = nx; }
        const unsigned old = xb_add(&bar[XB_XSUB(b.x)], 1u);
        const unsigned gen = old / nloc;
        if (old + 1u == (gen + 1u) * nloc) {
            __builtin_amdgcn_fence(__ATOMIC_RELEASE, "agent");
            asm volatile("s_waitcnt vmcnt(0)" ::: "memory");
            const unsigned og = xb_add(&bar[XB_TOP], 1u);
            const unsigned tg = og / nx;
            if (og + 1u == (tg + 1u) * nx) xb_add(&bar[XB_TOPGEN], 1u);
            else XB_SPIN(xb_ld(&bar[XB_TOPGEN]) == tg, bar);
            __builtin_amdgcn_fence(__ATOMIC_ACQUIRE, "agent");
            xb_add(&bar[XB_XGEN(b.x)], 1u);
            asm volatile("s_waitcnt vmcnt(0)" ::: "memory");
        } else {
            XB_SPIN(xb_ld(&bar[XB_XGEN(b.x)]) == gen, bar);
            __builtin_amdgcn_fence(__ATOMIC_ACQUIRE, "agent");
            asm volatile("s_waitcnt vmcnt(0)" ::: "memory");
        }
    }
    __syncthreads();
}

#define GRID_SYNC() do { asm volatile("s_waitcnt vmcnt(0) lgkmcnt(0)" ::: "memory"); __syncthreads(); if (wave == 0) { __builtin_amdgcn_fence(__ATOMIC_RELEASE, "agent"); asm volatile("s_waitcnt vmcnt(0)" ::: "memory"); } grid.sync(); __builtin_amdgcn_fence(__ATOMIC_ACQUIRE, "agent"); asm volatile("s_waitcnt vmcnt(0)" ::: "memory"); } while (0)
#define XCD_SYNC() do { xcd_barrier(xbar); } while (0)
#define XB_EXIT 3520
__device__ unsigned g_bar_words[4096];
__global__ void __launch_bounds__(NTHREADS, 2) fwd_megakernel(Args a) {
    extern __shared__ __attribute__((aligned(16))) unsigned char lds_raw[];
    LAS unsigned char* lds = (LAS unsigned char*)lds_raw;
    cg::grid_group grid = cg::this_grid();
    const int tid = threadIdx.x, lane = tid & 63, wave = __builtin_amdgcn_readfirstlane(tid >> 6);
    const int G = gridDim.x, gw = blockIdx.x * NWAVES + wave, NGW = G * NWAVES;
    unsigned char* ws = a.ws;
    volatile LAS unsigned* xst = (volatile LAS unsigned*)(lds + 131072 + 256);
    if (tid < 2) xst[tid] = 0u;
    __syncthreads();
    const XcdBarrier xbar = xcd_barrier_post(g_bar_words, xst);
    const char* H = (const char*)a.out;
    const char* WIN = (const char*)(ws + WS_WIN); const char* WPAB = (const char*)(ws + WS_WPAB); const char* WO = (const char*)(ws + WS_WO);
    bf16_t* ACT = (bf16_t*)(ws + WS_ACT);

    p0_prologue(a, lds, gw, NGW, wave, lane, tid);
    if (G == 0x7fffffff) GRID_SYNC();
    XCD_SYNC();

    {
        pg8::Sched S{}; S.nM = M / 256; S.nN = N1 / 256; S.nwg = S.nM * S.nN; S.G = G; S.c = blockIdx.x; S.reps = 1;
        S.A0 = S.A1 = S.A2 = S.A3 = H; S.B0 = S.B1 = S.B2 = S.B3 = WIN;
        pg8::EpiProj E{ACT};
        pg8::gemm_phase<pg8::EpiProj>(lds, S, E);
    }
    XCD_SYNC();

    if ((G & 7) == 0) { for (int j = blockIdx.x >> 3; j < 128; j += (G >> 3)) gla_pre(a, lds, (blockIdx.x & 7) * 128 + j, tid, lane, wave); }
    else { for (int it = blockIdx.x; it < 1024; it += G) gla_pre(a, lds, it, tid, lane, wave); }
    sb_mfma(a, lds, tid, lane, wave);
    XCD_SYNC();

    if (blockIdx.x < 64) { const int cix = blockIdx.x >> 3, citem = (blockIdx.x & 7) * 4 + (cix >> 1);
        if (cix & 1) gla_serial<1>(a, lds, citem, tid, lane, wave); else gla_serial<0>(a, lds, citem, tid, lane, wave); }
    else {
        pg8::Sched S{}; S.nM = M / 256; S.nN = 12; S.nwg = S.nM * S.nN; S.G = G - 64; S.c = blockIdx.x - 64; S.reps = 1; S.split = 8;
        S.A0 = S.A2 = S.A3 = H; S.A1 = (const char*)(ACT + (size_t)B_SG * (ACT_STRIDE / 2));
        S.B0 = S.B2 = S.B3 = WIN + (size_t)N1 * 2048; S.B1 = WPAB + (size_t)1024 * 2048;
        pg8::EpiGateYb E{pg8::EpiGate{(unsigned char*)(ACT + (size_t)B_SQ * (ACT_STRIDE / 2)), (unsigned char*)(ACT + (size_t)B_SK * (ACT_STRIDE / 2)), a.b_gate}, pg8::EpiRaw{ACT + (size_t)B_SV * (ACT_STRIDE / 2)}};
        pg8::gemm_phase<pg8::EpiGateYb>(lds, S, E);
    }
    XCD_SYNC();
    for (int it = blockIdx.x; it < 256; it += G) gla_fix(a, lds, it, tid, lane, wave);
    XCD_SYNC();
    {
        pg8::Sched S{}; S.nM = M / 256; S.nN = 4; S.nwg = S.nM * S.nN; S.G = G; S.c = blockIdx.x; S.reps = 1;
        S.A0 = S.A1 = S.A2 = S.A3 = (const char*)(ACT + (size_t)B_GG * (ACT_STRIDE / 2));
        S.B0 = S.B1 = S.B2 = S.B3 = WPAB;
        pg8::EpiMerge E{(const unsigned char*)(ACT + (size_t)B_SQ * (ACT_STRIDE / 2)), (const unsigned char*)(ACT + (size_t)B_SK * (ACT_STRIDE / 2)), ACT + (size_t)B_SV * (ACT_STRIDE / 2)};
        pg8::gemm_phase<pg8::EpiMerge>(lds, S, E);
    }
    XCD_SYNC();

    {
        pg8::Sched S{}; S.nM = M / 256; S.nN = 4; S.nwg = S.nM * S.nN; S.G = G; S.c = blockIdx.x; S.reps = 1;
        S.A0 = S.A1 = S.A2 = S.A3 = (const char*)(ACT + (size_t)B_SV * (ACT_STRIDE / 2)); S.B0 = S.B1 = S.B2 = S.B3 = WO;
        pg8::EpiRaw E{ACT + (size_t)B_GQK * (ACT_STRIDE / 2)};
        pg8::gemm_phase<pg8::EpiRaw>(lds, S, E);
    }
    XCD_SYNC();

    final_norm(a, gw, NGW, lane);
    if (tid == 0) { const unsigned old = __hip_atomic_fetch_add(g_bar_words + XB_EXIT, 1u, __ATOMIC_RELAXED, __HIP_MEMORY_SCOPE_AGENT); xst[0] = (old == (unsigned)G - 1u) ? 1u : 0u; }
    __syncthreads();
    if (xst[0] != 0u) { for (int i = tid; i < 4096; i += NTHREADS) __hip_atomic_store(g_bar_words + i, 0u, __ATOMIC_RELAXED, __HIP_MEMORY_SCOPE_AGENT); }
}

extern "C" void kernel_launch(void* const* d_in, const int* in_sizes, int n_in, void* d_out, int out_size, void* d_ws, size_t ws_size, hipStream_t stream) {
    static int grid = 0;
    if (grid == 0) {
        int dev = 0, cus = 0, per_cu = 0;
        hipGetDevice(&dev);
        hipDeviceGetAttribute(&cus, hipDeviceAttributeMultiprocessorCount, dev);
        if (hipFuncSetAttribute((const void*)fwd_megakernel, hipFuncAttributeMaxDynamicSharedMemorySize, LDS_BYTES) != hipSuccess) fprintf(stderr, "kernel_launch: hipFuncSetAttribute failed\n");
        if (hipOccupancyMaxActiveBlocksPerMultiprocessor(&per_cu, (const void*)fwd_megakernel, NTHREADS, LDS_BYTES) != hipSuccess || per_cu < 1) { fprintf(stderr, "kernel_launch: occupancy query says %d\n", per_cu); per_cu = 1; }
        (void)hipGetLastError();
        grid = cus * per_cu;
        if (ws_size < 256 * MiB) fprintf(stderr, "kernel_launch: workspace too small: %zu\n", ws_size);
    }
    Args a{};
    a.x = (const float*)d_in[0]; a.norm_g = (const float*)d_in[1]; a.w_in = (const float*)d_in[2]; a.w_dec_up = (const float*)d_in[3]; a.b_dec = (const float*)d_in[4];
    a.gla_norm_g = (const float*)d_in[5]; a.w_pa = (const float*)d_in[6]; a.w_pb = (const float*)d_in[7]; a.b_gate = (const float*)d_in[8]; a.w_o = (const float*)d_in[9];
    a.final_g = (const float*)d_in[10]; a.out = (float*)d_out; a.ws = (unsigned char*)d_ws;
    void* args[] = {&a};
    hipError_t e = hipLaunchCooperativeKernel((const void*)fwd_megakernel, dim3(grid), dim3(NTHREADS), args, LDS_BYTES, stream);
    if (e != hipSuccess) fprintf(stderr, "kernel_launch: cooperative launch failed: %s (grid %d)\n", hipGetErrorString(e), grid);
}
```

```cpp
#include <hip/hip_runtime.h>
#include <hip/hip_cooperative_groups.h>
#include <cstdio>
#include <cstdint>
namespace cg = cooperative_groups;

#define LAS __attribute__((address_space(3)))
#define GAS __attribute__((address_space(1)))
typedef unsigned short bf16_t;
typedef short bf16x8 __attribute__((ext_vector_type(8)));
typedef float f32x4 __attribute__((ext_vector_type(4)));
typedef float f32x2 __attribute__((ext_vector_type(2)));
typedef unsigned u32x4 __attribute__((ext_vector_type(4)));
typedef unsigned u32x2 __attribute__((ext_vector_type(2)));

constexpr int D = 1024, BATCH = 8, SEQ = 2048, M = BATCH * SEQ;
constexpr int IN_COLS = 9232, RANK_OFF = 3072, NP = 9216;
constexpr int N1 = 7168;
constexpr float EPS = 1e-6f;
constexpr int NWAVES = 8, NTHREADS = 512;

constexpr size_t MiB = 1u << 20;
constexpr size_t WS_RANK = 1 * MiB;
constexpr size_t WS_WIN = 2 * MiB;
constexpr size_t WS_WPAB = 20 * MiB;
constexpr size_t WS_WO = 24 * MiB;
constexpr size_t WS_ACT = 32 * MiB;
constexpr size_t ACT_STRIDE = 32 * MiB;
constexpr int B_GQK = 0, B_GV = 1, B_GG = 2, B_SQ = 3, B_SK = 4, B_SV = 5, B_SG = 6;
constexpr int LDS_BYTES = 147456;

typedef __bf16 bf16x2_hw __attribute__((ext_vector_type(2)));
__device__ __forceinline__ unsigned pk2(float lo, float hi) { f32x2 v = {lo, hi}; bf16x2_hw b = __builtin_convertvector(v, bf16x2_hw); return __builtin_bit_cast(unsigned, b); }
__device__ __forceinline__ unsigned f2bf(float f) { return pk2(f, 0.f) & 0xffffu; }
__device__ __forceinline__ float bf2f(unsigned short b) { return __builtin_bit_cast(float, (unsigned)b << 16); }
__device__ __forceinline__ float bflo(unsigned w) { return __builtin_bit_cast(float, w << 16); }
__device__ __forceinline__ float bfhi(unsigned w) { return __builtin_bit_cast(float, w & 0xffff0000u); }
__device__ __forceinline__ unsigned cvt_pk_bf16(float lo, float hi) { unsigned r; asm volatile("v_cvt_pk_bf16_f32 %0, %1, %2" : "=v"(r) : "v"(lo), "v"(hi)); return r; }
__device__ __forceinline__ float wave_sum(float v) {
#pragma unroll
    for (int o = 1; o < 64; o <<= 1) v += __shfl_xor(v, o);
    return v;
}
__device__ __forceinline__ float sigmoidf_(float v) { return __builtin_amdgcn_rcpf(1.f + __expf(-v)); }
__device__ __forceinline__ float siluf_(float v) { return v * __builtin_amdgcn_rcpf(1.f + __expf(-v)); }
#define LDS_WAIT() asm volatile("s_waitcnt lgkmcnt(0)" ::: "memory")

namespace pg8 {
constexpr int BM = 256, BK = 64, HALF = 128, HTB = HALF * BK * 2, STAGE_BYTES = 8 * HTB, NXCD = 8, WGM = 8;
__host__ __device__ __forceinline__ int lds_byte(int r, int c) { const int st = (r >> 4) * 2 + (c >> 5), rr = r & 15, cc = c & 31, ob = rr * 64 + cc * 2; return st * 1024 + (ob ^ (((ob >> 9) & 1) << 5)); }
__host__ __device__ __forceinline__ void stage_rc(int b, int& R, int& C) { const int st = b / 1024, sb = b % 1024, swz = sb ^ (((sb >> 9) & 1) << 5); R = (st >> 1) * 16 + swz / 64; C = (st & 1) * 32 + (swz % 64) / 2; }
__host__ __device__ __forceinline__ int perm32(int rho) { const int n = rho >> 4, i = rho & 15; return 8 * (i >> 2) + 4 * n + (i & 3); }

struct Unit { int pm, pn, kind; };
__device__ __forceinline__ void zero_acc(f32x4 (&acc)[2][2][4][2]) {
#pragma unroll
    for (int a = 0; a < 2; ++a)
#pragma unroll
        for (int b = 0; b < 2; ++b)
#pragma unroll
            for (int m = 0; m < 4; ++m)
#pragma unroll
                for (int n = 0; n < 2; ++n) acc[a][b][m][n] = (f32x4){0.f, 0.f, 0.f, 0.f};
}

struct Sched {
    int nM, nN, nwg, G, c, reps, split;
    const char* A0; const char* A1; const char* A2; const char* A3;
    const char* B0; const char* B1; const char* B2; const char* B3;
    __device__ __forceinline__ bool next(int i, Unit& u) const {
        const int ti = i / reps; u.kind = i - ti * reps;
        const long L = (long)ti * G + c; if (L >= nwg) return false;
        int wgid = (int)L; { const int q = nwg / NXCD, r = nwg % NXCD, xcd = wgid % NXCD, off = wgid / NXCD; wgid = (xcd < r ? xcd * (q + 1) : r * (q + 1) + (xcd - r) * q) + off; }
        const int nig = WGM * nN, gid = wgid / nig, fm = gid * WGM, gsz = (nM - fm) < WGM ? (nM - fm) : WGM;
        u.pm = fm + ((wgid % nig) % gsz); u.pn = (wgid % nig) / gsz;
        if (split > 0 && u.pn >= split) { u.kind = 1; u.pn -= split; }
        return true;
    }
    __device__ __forceinline__ const char* aptr(const Unit& u) const { const char* b = u.kind == 0 ? A0 : (u.kind == 1 ? A1 : (u.kind == 2 ? A2 : A3)); return b + (size_t)u.pm * (256 * 1024 * 2); }
    __device__ __forceinline__ const char* bptr(const Unit& u) const { const char* b = u.kind == 0 ? B0 : (u.kind == 1 ? B1 : (u.kind == 2 ? B2 : B3)); return b + (size_t)u.pn * (256 * 1024 * 2); }
};

template <class Epi>
__device__ __forceinline__ void gemm_phase(LAS unsigned char* lds, const Sched& S, const Epi& E) {
    const int tid = threadIdx.x, wid = __builtin_amdgcn_readfirstlane(tid >> 6), lane = tid & 63, wr = wid >> 2, wc = wid & 3, fr = lane & 15, fq = lane >> 4;
    constexpr int K = 1024, nt = K / BK;
    unsigned voffA[2], voffB[2];
#pragma unroll
    for (int i = 0; i < 2; ++i) { int R, C; stage_rc(tid * 16 + i * 8192, R, C); const int Rb = (R & ~31) + perm32(R & 31);
        voffA[i] = (unsigned)(R * K + C) * 2u; voffB[i] = (unsigned)(Rb * K + C) * 2u; }
    const size_t kstep = (size_t)(BK * 2);
    const size_t hstep = (size_t)HALF * K * 2;
    const unsigned ldsw = (unsigned)wid * 1024u;
    const int aoff = lds_byte(wr * 64 + fr, fq * 8), boff = lds_byte(wc * 32 + fr, fq * 8);
#define PG8_SA(b, h) (((b) * 2 + (h)) * HTB)
#define PG8_SB(b, h) ((4 + (b) * 2 + (h)) * HTB)
#define PG8_STAGE(bufoff, gbase, voff) do { _Pragma("unroll") for (int _i = 0; _i < 2; ++_i) \
        __builtin_amdgcn_global_load_lds((const unsigned*)((const char*)(gbase) + (voff)[_i]), (LAS unsigned*)(lds + (bufoff) + ldsw + _i * 8192), 16, 0, 0); } while (0)
#define PG8_LDA(dst, b, h) do { _Pragma("unroll") for (int m = 0; m < 4; ++m) _Pragma("unroll") for (int k = 0; k < 2; ++k) dst[m][k] = *(const LAS bf16x8*)(lds + PG8_SA(b, h) + aoff + m * 2048 + k * 1024); } while (0)
#define PG8_LDB(dst, b, h) do { _Pragma("unroll") for (int n = 0; n < 2; ++n) _Pragma("unroll") for (int k = 0; k < 2; ++k) dst[n][k] = *(const LAS bf16x8*)(lds + PG8_SB(b, h) + boff + n * 2048 + k * 1024); } while (0)
#define PG8_MMA(ai, bj, At, Bt) do { __builtin_amdgcn_s_setprio(1); _Pragma("unroll") for (int m = 0; m < 4; ++m) _Pragma("unroll") for (int n = 0; n < 2; ++n) _Pragma("unroll") for (int k = 0; k < 2; ++k) \
        acc[ai][bj][m][n] = __builtin_amdgcn_mfma_f32_16x16x32_bf16(Bt[n][k], At[m][k], acc[ai][bj][m][n], 0, 0, 0); __builtin_amdgcn_s_setprio(0); } while (0)
#define PG8_WAIT_V(n) asm volatile("s_waitcnt vmcnt(" #n ")" ::: "memory")
#define PG8_WAIT_L(n) asm volatile("s_waitcnt lgkmcnt(" #n ")" ::: "memory")
#define PG8_BAR __builtin_amdgcn_s_barrier()
#define PG8_SCHED __builtin_amdgcn_sched_barrier(0)
    Unit cur, nxt; int ui = 0;
    if (!S.next(0, cur)) return;
    f32x4 acc[2][2][4][2];
#pragma unroll
    for (int a = 0; a < 2; ++a)
#pragma unroll
        for (int b = 0; b < 2; ++b)
#pragma unroll
            for (int m = 0; m < 4; ++m)
#pragma unroll
                for (int n = 0; n < 2; ++n) acc[a][b][m][n] = (f32x4){0.f, 0.f, 0.f, 0.f};
    bf16x8 At[4][2], B0[2][2], B1[2][2];
    const char* cA = S.aptr(cur); const char* cB = S.bptr(cur);
    PG8_STAGE(PG8_SB(0, 0), cB, voffB); PG8_STAGE(PG8_SB(0, 1), cB + hstep, voffB); PG8_STAGE(PG8_SA(0, 0), cA, voffA); PG8_STAGE(PG8_SA(0, 1), cA + hstep, voffA);
    if (wr == 1) PG8_BAR;
    PG8_WAIT_V(2); PG8_BAR;
    PG8_STAGE(PG8_SB(1, 0), cB + kstep, voffB); PG8_STAGE(PG8_SA(1, 0), cA + kstep, voffA); PG8_STAGE(PG8_SB(1, 1), cB + hstep + kstep, voffB);
    PG8_WAIT_V(6); PG8_BAR;
    for (;;) {
        const bool has_next = S.next(ui + 1, nxt);
        const char* nA = has_next ? S.aptr(nxt) : cA; const char* nB = has_next ? S.bptr(nxt) : cB;
        for (int t = 0; t < nt; t += 2) {
            const bool last = (t == nt - 2);
            const char* a1 = cA + (size_t)(t + 1) * kstep;
            const char* a2 = last ? nA : cA + (size_t)(t + 2) * kstep; const char* b2 = last ? nB : cB + (size_t)(t + 2) * kstep;
            const char* a3 = a2 + kstep; const char* b3 = b2 + kstep;
            PG8_LDB(B0, 0, 0); PG8_LDB(B1, 0, 1); PG8_SCHED; PG8_LDA(At, 0, 0); PG8_STAGE(PG8_SA(1, 1), a1 + hstep, voffA);
            PG8_WAIT_V(8); PG8_WAIT_L(0); PG8_BAR; PG8_MMA(0, 0, At, B0); PG8_MMA(0, 1, At, B1); PG8_BAR; PG8_SCHED;
            PG8_LDA(At, 0, 1); PG8_STAGE(PG8_SB(0, 0), b2, voffB); PG8_STAGE(PG8_SB(0, 1), b2 + hstep, voffB); PG8_STAGE(PG8_SA(0, 0), a2, voffA);
            PG8_WAIT_V(8); PG8_WAIT_L(0); PG8_BAR; PG8_MMA(1, 0, At, B0); PG8_MMA(1, 1, At, B1); PG8_BAR; PG8_SCHED;
            PG8_LDB(B0, 1, 0); PG8_LDB(B1, 1, 1); PG8_SCHED; PG8_LDA(At, 1, 0); PG8_STAGE(PG8_SA(0, 1), a2 + hstep, voffA);
            PG8_WAIT_V(8); PG8_WAIT_L(0); PG8_BAR; PG8_MMA(0, 0, At, B0); PG8_MMA(0, 1, At, B1); PG8_BAR; PG8_SCHED;
            PG8_LDA(At, 1, 1); PG8_STAGE(PG8_SB(1, 0), b3, voffB); PG8_STAGE(PG8_SB(1, 1), b3 + hstep, voffB); PG8_STAGE(PG8_SA(1, 0), a3, voffA);
            PG8_WAIT_V(8); PG8_WAIT_L(0); PG8_BAR; PG8_MMA(1, 0, At, B0); PG8_MMA(1, 1, At, B1); PG8_BAR; PG8_SCHED;
        }
        if (wr == 0) PG8_BAR;
        E(acc, cur, wr, wc, fr, fq);
        if (!has_next) break;
        zero_acc(acc);
        cur = nxt; cA = nA; cB = nB; ++ui;
        if (wr == 1) PG8_BAR;
    }
    PG8_WAIT_V(0);
    PG8_BAR;
#undef PG8_SA
#undef PG8_SB
#undef PG8_STAGE
#undef PG8_LDA
#undef PG8_LDB
#undef PG8_MMA
#undef PG8_WAIT_V
#undef PG8_WAIT_L
#undef PG8_BAR
#undef PG8_SCHED
}

struct EpiProj {
    bf16_t* act;
    __device__ __forceinline__ bool operator()(const f32x4 (&acc)[2][2][4][2], const Unit& u, int wr, int wc, int fr, int fq) const {
        const int t = u.pn >> 2; const bool gate = (t == B_GG) || (t == B_SG);
        bf16_t* base = act + (size_t)t * (ACT_STRIDE / 2);
        const int row0 = u.pm * BM + wr * 64 + fr, col0 = (u.pn & 3) * 256 + wc * 32 + 8 * fq;
#pragma unroll
        for (int ai = 0; ai < 2; ++ai)
#pragma unroll
            for (int m = 0; m < 4; ++m) { bf16_t* rowp = base + (size_t)(row0 + ai * HALF + m * 16) * 1024 + col0;
#pragma unroll
                for (int bj = 0; bj < 2; ++bj) { f32x4 v0 = acc[ai][bj][m][0], v1 = acc[ai][bj][m][1];
                    if (gate) {
#pragma unroll
                        for (int e = 0; e < 4; ++e) { v0[e] = siluf_(v0[e]); v1[e] = siluf_(v1[e]); } }
                    u32x4 w; w.x = cvt_pk_bf16(v0[0], v0[1]); w.y = cvt_pk_bf16(v0[2], v0[3]); w.z = cvt_pk_bf16(v1[0], v1[1]); w.w = cvt_pk_bf16(v1[2], v1[3]);
                    *(u32x4*)(rowp + bj * HALF) = w; } }
        return false;
    }
};
struct EpiMerge {
    const unsigned char* ga; const unsigned char* gb; bf16_t* merged;
    __device__ __forceinline__ bool operator()(const f32x4 (&acc)[2][2][4][2], const Unit& u, int wr, int wc, int fr, int fq) const {
        const int row0 = u.pm * BM + wr * 64 + fr, col0 = u.pn * 256 + wc * 32 + 8 * fq;
#pragma unroll
        for (int ai = 0; ai < 2; ++ai)
#pragma unroll
            for (int m = 0; m < 4; ++m) { const size_t off = (size_t)(row0 + ai * HALF + m * 16) * 1024 + col0;
#pragma unroll
                for (int bj = 0; bj < 2; ++bj) {
                    const u32x2 wa = *(const u32x2*)(ga + off + bj * HALF), wb = *(const u32x2*)(gb + off + bj * HALF); const u32x4 wy = *(const u32x4*)(merged + off + bj * HALF);
                    const float k255 = 1.f / 255.f;
                    float g[8] = {(float)(wa.x & 255u) * k255, (float)((wa.x >> 8) & 255u) * k255, (float)((wa.x >> 16) & 255u) * k255, (float)(wa.x >> 24) * k255, (float)(wa.y & 255u) * k255, (float)((wa.y >> 8) & 255u) * k255, (float)((wa.y >> 16) & 255u) * k255, (float)(wa.y >> 24) * k255};
                    float q[8] = {(float)(wb.x & 255u) * k255, (float)((wb.x >> 8) & 255u) * k255, (float)((wb.x >> 16) & 255u) * k255, (float)(wb.x >> 24) * k255, (float)(wb.y & 255u) * k255, (float)((wb.y >> 8) & 255u) * k255, (float)((wb.y >> 16) & 255u) * k255, (float)(wb.y >> 24) * k255};
                    float y[8] = {bflo(wy.x), bfhi(wy.x), bflo(wy.y), bfhi(wy.y), bflo(wy.z), bfhi(wy.z), bflo(wy.w), bfhi(wy.w)};
                    f32x4 v0 = acc[ai][bj][m][0], v1 = acc[ai][bj][m][1];
#pragma unroll
                    for (int e = 0; e < 4; ++e) { v0[e] = v0[e] * g[e] + q[e] * y[e]; v1[e] = v1[e] * g[4 + e] + q[4 + e] * y[4 + e]; }
                    u32x4 w; w.x = cvt_pk_bf16(v0[0], v0[1]); w.y = cvt_pk_bf16(v0[2], v0[3]); w.z = cvt_pk_bf16(v1[0], v1[1]); w.w = cvt_pk_bf16(v1[2], v1[3]);
                    *(u32x4*)(merged + off + bj * HALF) = w; }
                __builtin_amdgcn_sched_barrier(0); }
        return false;
    }
};
struct EpiRaw {
    bf16_t* out;
    __device__ __forceinline__ bool operator()(const f32x4 (&acc)[2][2][4][2], const Unit& u, int wr, int wc, int fr, int fq) const {
        const int row0 = u.pm * BM + wr * 64 + fr, col0 = u.pn * 256 + wc * 32 + 8 * fq;
#pragma unroll
        for (int ai = 0; ai < 2; ++ai)
#pragma unroll
            for (int m = 0; m < 4; ++m) { bf16_t* rowp = out + (size_t)(row0 + ai * HALF + m * 16) * 1024 + col0;
#pragma unroll
                for (int bj = 0; bj < 2; ++bj) { const f32x4 v0 = acc[ai][bj][m][0], v1 = acc[ai][bj][m][1];
                    u32x4 w; w.x = cvt_pk_bf16(v0[0], v0[1]); w.y = cvt_pk_bf16(v0[2], v0[3]); w.z = cvt_pk_bf16(v1[0], v1[1]); w.w = cvt_pk_bf16(v1[2], v1[3]);
                    *(u32x4*)(rowp + bj * HALF) = w; } }
        return false;
    }
};
struct EpiGate {
    unsigned char* ga; unsigned char* gb; const float* b_gate;
    __device__ __forceinline__ bool operator()(const f32x4 (&acc)[2][2][4][2], const Unit& u, int wr, int wc, int fr, int fq) const {
        const int br = u.pn >> 2; unsigned char* base = br == 0 ? ga : gb;
        const int row0 = u.pm * BM + wr * 64 + fr, col0 = (u.pn & 3) * 256 + wc * 32 + 8 * fq; const float* bp = b_gate + br * 1024 + col0;
#pragma unroll
        for (int ai = 0; ai < 2; ++ai)
#pragma unroll
            for (int m = 0; m < 4; ++m) { unsigned char* rowp = base + (size_t)(row0 + ai * HALF + m * 16) * 1024 + col0;
#pragma unroll
                for (int bj = 0; bj < 2; ++bj) { f32x4 v0 = acc[ai][bj][m][0], v1 = acc[ai][bj][m][1];
#pragma unroll
                    for (int e = 0; e < 4; ++e) { v0[e] = sigmoidf_(v0[e] + bp[bj * HALF + e]); v1[e] = sigmoidf_(v1[e] + bp[bj * HALF + 4 + e]); }
                    u32x2 w;
                    w.x = (unsigned)(v0[0] * 255.f + 0.5f) | ((unsigned)(v0[1] * 255.f + 0.5f) << 8) | ((unsigned)(v0[2] * 255.f + 0.5f) << 16) | ((unsigned)(v0[3] * 255.f + 0.5f) << 24);
                    w.y = (unsigned)(v1[0] * 255.f + 0.5f) | ((unsigned)(v1[1] * 255.f + 0.5f) << 8) | ((unsigned)(v1[2] * 255.f + 0.5f) << 16) | ((unsigned)(v1[3] * 255.f + 0.5f) << 24);
                    *(u32x2*)(rowp + bj * HALF) = w; } }
        return false;
    }
};
struct EpiGateYb {
    EpiGate g; EpiRaw r;
    __device__ __forceinline__ bool operator()(const f32x4 (&acc)[2][2][4][2], const Unit& u, int wr, int wc, int fr, int fq) const {
        if (u.kind == 0) return g(acc, u, wr, wc, fr, fq);
        return r(acc, u, wr, wc, fr, fq);
    }
};
struct EpiOut {
    const float* x; bf16_t* pre;
    __device__ __forceinline__ bool operator()(const f32x4 (&acc)[2][2][4][2], const Unit& u, int wr, int wc, int fr, int fq) const {
        const int row0 = u.pm * BM + wr * 64 + fr, col0 = u.pn * 256 + wc * 32 + 8 * fq;
#pragma unroll
        for (int ai = 0; ai < 2; ++ai)
#pragma unroll
            for (int m = 0; m < 4; ++m) { const size_t off = (size_t)(row0 + ai * HALF + m * 16) * 1024 + col0;
#pragma unroll
                for (int bj = 0; bj < 2; ++bj) {
                    const f32x4 v0 = acc[ai][bj][m][0] + *(const f32x4*)(x + off + bj * HALF), v1 = acc[ai][bj][m][1] + *(const f32x4*)(x + off + bj * HALF + 4);
                    u32x4 w; w.x = cvt_pk_bf16(v0[0], v0[1]); w.y = cvt_pk_bf16(v0[2], v0[3]); w.z = cvt_pk_bf16(v1[0], v1[1]); w.w = cvt_pk_bf16(v1[2], v1[3]);
                    *(u32x4*)(pre + off + bj * HALF) = w; } }
        return false;
    }
};
}

struct Args {
    const float* x; const float* norm_g; const float* w_in; const float* w_dec_up; const float* b_dec; const float* gla_norm_g;
    const float* w_pa; const float* w_pb; const float* b_gate; const float* w_o; const float* final_g;
    float* out; unsigned char* ws;
};

__device__ __forceinline__ void p0_transpose_item(const float* W, int K, int ld, int nblk, bf16_t* WT, int row_off, LAS float* scr, int item, int lane) {
    const int kb = item / nblk, nb = item % nblk, k0 = 64 * kb, n0 = 32 * nb;
    float tv[32];
#pragma unroll
    for (int i = 0; i < 32; ++i) tv[i] = __builtin_nontemporal_load(W + (size_t)(k0 + 2 * i + (lane >> 5)) * ld + n0 + (lane & 31));
#pragma unroll
    for (int i = 0; i < 32; ++i) scr[(2 * i + (lane >> 5)) * 33 + (lane & 31)] = tv[i];
    LDS_WAIT(); asm volatile("" ::: "memory");
    const int c = lane & 7;
#pragma unroll
    for (int j = 0; j < 4; ++j) { const int n = (lane >> 3) + 8 * j; const LAS float* s = scr + (8 * c) * 33 + n;
        u32x4 o; o.x = pk2(s[0 * 33], s[1 * 33]); o.y = pk2(s[2 * 33], s[3 * 33]); o.z = pk2(s[4 * 33], s[5 * 33]); o.w = pk2(s[6 * 33], s[7 * 33]);
        *(u32x4*)(WT + (size_t)(row_off + n0 + n) * K + k0 + 8 * c) = o; }
    LDS_WAIT(); asm volatile("" ::: "memory");
}

__device__ __forceinline__ void p0_prologue(const Args& a, LAS unsigned char* lds, int gw, int NGW, int wave, int lane, int tid) {
    bf16_t* WIN = (bf16_t*)(a.ws + WS_WIN); bf16_t* WPAB = (bf16_t*)(a.ws + WS_WPAB); bf16_t* WO = (bf16_t*)(a.ws + WS_WO);
    float* grank = (float*)(a.ws + WS_RANK);
    bf16_t* H = (bf16_t*)a.out;
    LAS float* scr = (LAS float*)(lds + wave * 16384);
    constexpr int I1 = 16 * 96, I2 = 16 * 192, I3 = 16 * 32;
    constexpr int NITEMS = I1 + I2 + 3 * I3;
    for (int it = gw; it < NITEMS; it += NGW) {
        int r = it;
        if (r < I1) { p0_transpose_item(a.w_in, 1024, IN_COLS, 96, WIN, 0, scr, r, lane); continue; } r -= I1;
        if (r < I2) { p0_transpose_item(a.w_in + 3088, 1024, IN_COLS, 192, WIN, 3072, scr, r, lane); continue; } r -= I2;
        if (r < I3) { p0_transpose_item(a.w_pa, 1024, 1024, 32, WPAB, 0, scr, r, lane); continue; } r -= I3;
        if (r < I3) { p0_transpose_item(a.w_pb, 1024, 1024, 32, WPAB, 1024, scr, r, lane); continue; } r -= I3;
        p0_transpose_item(a.w_o, 1024, 1024, 32, WO, 0, scr, r, lane);
    }
    __syncthreads();
    LAS float* wrt = (LAS float*)lds;
    for (int e = tid; e < 1024 * 16; e += NTHREADS) { const int k = e >> 4, r = e & 15; wrt[r * 1024 + k] = a.w_in[(size_t)k * IN_COLS + RANK_OFF + r]; }
    __syncthreads();
    f32x4 nv[4];
    { const f32x4* xr0 = (const f32x4*)(a.x + (size_t)gw * D) + lane;
#pragma unroll
      for (int j = 0; j < 4; ++j) nv[j] = __builtin_nontemporal_load(xr0 + 64 * j); }
    for (int m = gw; m < M; m += NGW) {
        const f32x4* gr = (const f32x4*)a.norm_g + lane;
        f32x4 v[4]; float s2 = 0.f;
#pragma unroll
        for (int j = 0; j < 4; ++j) { v[j] = nv[j]; s2 += (v[j].x * v[j].x + v[j].y * v[j].y) + (v[j].z * v[j].z + v[j].w * v[j].w); }
        if (m + NGW < M) { const f32x4* xn = (const f32x4*)(a.x + (size_t)(m + NGW) * D) + lane;
#pragma unroll
            for (int j = 0; j < 4; ++j) nv[j] = __builtin_nontemporal_load(xn + 64 * j); }
        const float rstd = 1.f / sqrtf(wave_sum(s2) * (1.f / D) + EPS);
#pragma unroll
        for (int j = 0; j < 4; ++j) v[j] = v[j] * rstd * gr[64 * j];
        unsigned long long* o8 = (unsigned long long*)(H + (size_t)m * D) + lane;
#pragma unroll
        for (int j = 0; j < 4; ++j) o8[64 * j] = (unsigned long long)pk2(v[j].x, v[j].y) | ((unsigned long long)pk2(v[j].z, v[j].w) << 32);
        float acc16[16];
#pragma unroll
        for (int r = 0; r < 16; ++r) { float p = 0.f;
#pragma unroll
            for (int j = 0; j < 4; ++j) { const f32x4 w = *(const LAS f32x4*)(wrt + r * 1024 + 256 * j + 4 * lane); p += (v[j].x * w.x + v[j].y * w.y) + (v[j].z * w.z + v[j].w * w.w); }
            acc16[r] = p; __builtin_amdgcn_sched_barrier(0); }
        float a8[8], a4[4], a2[2];
#pragma unroll
        for (int r = 0; r < 8; ++r) { const bool up = (lane & 32) != 0; const float send = up ? acc16[r] : acc16[r + 8], keep = up ? acc16[r + 8] : acc16[r]; a8[r] = keep + __shfl_xor(send, 32); }
#pragma unroll
        for (int r = 0; r < 4; ++r) { const bool up = (lane & 16) != 0; const float send = up ? a8[r] : a8[r + 4], keep = up ? a8[r + 4] : a8[r]; a4[r] = keep + __shfl_xor(send, 16); }
#pragma unroll
        for (int r = 0; r < 2; ++r) { const bool up = (lane & 8) != 0; const float send = up ? a4[r] : a4[r + 2], keep = up ? a4[r + 2] : a4[r]; a2[r] = keep + __shfl_xor(send, 8); }
        float a1; { const bool up = (lane & 4) != 0; const float send = up ? a2[0] : a2[1], keep = up ? a2[1] : a2[0]; a1 = keep + __shfl_xor(send, 4); }
        a1 += __shfl_xor(a1, 2); a1 += __shfl_xor(a1, 1);
        if ((lane & 3) == 0) { const int rk = ((lane >> 5) & 1) * 8 + ((lane >> 4) & 1) * 4 + ((lane >> 3) & 1) * 2 + ((lane >> 2) & 1); grank[(size_t)m * 16 + rk] = a1; }
    }
}

typedef float f32x16 __attribute__((ext_vector_type(16)));
typedef short v4i16_t __attribute__((ext_vector_type(4)));
typedef __bf16 bf16x2_t __attribute__((ext_vector_type(2)));
__device__ __forceinline__ unsigned cvtpk(float lo, float hi) { f32x2 v = {lo, hi}; bf16x2_t b = __builtin_convertvector(v, bf16x2_t); return __builtin_bit_cast(unsigned, b); }
__device__ __forceinline__ v4i16_t vtr(LAS unsigned char* p) { return __builtin_amdgcn_ds_read_tr16_b64_v4i16((LAS v4i16_t*)p); }
__device__ __forceinline__ void sb_mfma(const Args& a, LAS unsigned char* lds, int tid, int lane, int wave) {
    const bf16_t* SQ = (const bf16_t*)(a.ws + WS_ACT + B_SQ * ACT_STRIDE); const bf16_t* SK = (const bf16_t*)(a.ws + WS_ACT + B_SK * ACT_STRIDE);
    const bf16_t* SV = (const bf16_t*)(a.ws + WS_ACT + B_SV * ACT_STRIDE); bf16_t* SG = (bf16_t*)(a.ws + WS_ACT + B_SG * ACT_STRIDE);
    constexpr int RS = 272;
    LAS unsigned char* Kl = lds; LAS unsigned char* Vl = lds + 64 * RS;
    const int h = lane >> 5, r32 = lane & 31, i16 = lane & 15, tq = i16 >> 2, tp = i16 & 3, blk = (lane >> 4) & 1;
    const int lrow = tid >> 3, lseg = tid & 7;
    const float C2 = 0.08838834764831845f * 1.4426950408889634f;
    for (int pi = blockIdx.x; pi < 256; pi += gridDim.x) {
#pragma unroll 1
        for (int half = 0; half < 2; ++half) {
            const int ps = (pi & 7) * 32 + (pi >> 3);
            const int bh = ps >> 2, qb = half == 0 ? (ps & 3) : 7 - (ps & 3), b = bh >> 3, hh = bh & 7;
            const int q0 = 256 * qb + 32 * wave;
            bf16x8 qf[8];
            { const bf16_t* qp = SQ + ((size_t)b * SEQ + q0 + r32) * 1024 + hh * 128 + 8 * h;
#pragma unroll
              for (int s = 0; s < 8; ++s) qf[s] = *(const bf16x8*)(qp + 16 * s); }
            f32x16 o[4];
#pragma unroll
            for (int d = 0; d < 4; ++d)
#pragma unroll
                for (int i = 0; i < 16; ++i) o[d][i] = 0.f;
            float R = 0.f; int wdone = 0;
            LAS int* donef = (LAS int*)(lds + 2 * 64 * RS);
            __syncthreads();
            if (lane == 0) donef[wave] = 0;
            const int nkt = 4 * qb + 4;
            const bf16_t* kbase = SK + ((size_t)b * SEQ + lrow) * 1024 + hh * 128 + lseg * 16;
            const bf16_t* vbase = SV + ((size_t)b * SEQ + lrow) * 1024 + hh * 128 + lseg * 16;
            u32x4 kr0, kr1, vr0, vr1;
            { const size_t off = (size_t)(nkt - 1) * 64 * 1024; kr0 = *(const u32x4*)(kbase + off); kr1 = *(const u32x4*)(kbase + off + 8); vr0 = *(const u32x4*)(vbase + off); vr1 = *(const u32x4*)(vbase + off + 8); }
#pragma unroll 1
            for (int kt = nkt - 1; kt >= 0; --kt) {
                __syncthreads();
                if ((donef[0] & donef[1] & donef[2] & donef[3] & donef[4] & donef[5] & donef[6] & donef[7]) != 0) break;
                *(LAS u32x4*)(Kl + lrow * RS + lseg * 32) = kr0; *(LAS u32x4*)(Kl + lrow * RS + lseg * 32 + 16) = kr1;
                *(LAS u32x4*)(Vl + lrow * RS + lseg * 32) = vr0; *(LAS u32x4*)(Vl + lrow * RS + lseg * 32 + 16) = vr1;
                __syncthreads();
                if (kt > 0) { const size_t off = (size_t)(kt - 1) * 64 * 1024; kr0 = *(const u32x4*)(kbase + off); kr1 = *(const u32x4*)(kbase + off + 8); vr0 = *(const u32x4*)(vbase + off); vr1 = *(const u32x4*)(vbase + off + 8); }
                if (64 * kt <= q0 + 30 && !wdone) {
#pragma unroll 1
                    for (int st = 1; st >= 0; --st) {
                        f32x16 z;
#pragma unroll
                        for (int i = 0; i < 16; ++i) z[i] = 0.f;
#pragma unroll
                        for (int s = 0; s < 8; ++s) { const bf16x8 kf = *(const LAS bf16x8*)(Kl + (32 * st + r32) * RS + (16 * s + 8 * h) * 2); z = __builtin_amdgcn_mfma_f32_32x32x16_bf16(kf, qf[s], z, 0, 0, 0); }
                        const int kabs0 = 64 * kt + 32 * st + 4 * h, qabs = q0 + r32; const bool full = (64 * kt + 64 <= q0);
                        float ls[16], lm[16];
                        if (full) {
#pragma unroll
                            for (int i = 0; i < 16; ++i) { const float z2 = z[i] * C2; const float e = __builtin_amdgcn_exp2f(-fabsf(z2)); const float l2 = __builtin_amdgcn_logf(1.f + e);
                                const float l = fminf(z2, 0.f) - l2; ls[i] = l; lm[i] = l - z2; }
                        } else {
#pragma unroll
                            for (int i = 0; i < 16; ++i) { const float z2 = z[i] * C2; const float e = __builtin_amdgcn_exp2f(-fabsf(z2)); const float l2 = __builtin_amdgcn_logf(1.f + e);
                                const float l = fminf(z2, 0.f) - l2; const bool valid = (kabs0 + (i & 3) + 8 * (i >> 2)) < qabs; ls[i] = valid ? l : -1e30f; lm[i] = valid ? (l - z2) : 0.f; }
                        }
                        float To[4], Tp[4], G[4];
#pragma unroll
                        for (int g = 0; g < 4; ++g) To[g] = (lm[4 * g] + lm[4 * g + 1]) + (lm[4 * g + 2] + lm[4 * g + 3]);
#pragma unroll
                        for (int g = 0; g < 4; ++g) Tp[g] = __shfl_xor(To[g], 32);
                        G[3] = 0.f; G[2] = To[3] + Tp[3]; G[1] = G[2] + (To[2] + Tp[2]); G[0] = G[1] + (To[1] + Tp[1]);
                        const float total = G[0] + (To[0] + Tp[0]);
                        float A[16];
#pragma unroll
                        for (int g = 0; g < 4; ++g) { const float base = R + G[g] + (h == 0 ? Tp[g] : 0.f);
                            const float c3 = base, c2 = c3 + lm[4 * g + 3], c1 = c2 + lm[4 * g + 2], c0 = c1 + lm[4 * g + 1];
                            A[4 * g + 3] = __builtin_amdgcn_exp2f(ls[4 * g + 3] + c3); A[4 * g + 2] = __builtin_amdgcn_exp2f(ls[4 * g + 2] + c2);
                            A[4 * g + 1] = __builtin_amdgcn_exp2f(ls[4 * g + 1] + c1); A[4 * g] = __builtin_amdgcn_exp2f(ls[4 * g] + c0); }
                        R += total;
                        { const int alld = __all(R < -151.f) ? 1 : 0; if (st == 0) { wdone = alld; if (lane == 0) donef[wave] = alld; } }
                        u32x4 p0, p1;
                        p0.x = cvtpk(A[0], A[1]); p0.y = cvtpk(A[2], A[3]); p0.z = cvtpk(A[4], A[5]); p0.w = cvtpk(A[6], A[7]);
                        p1.x = cvtpk(A[8], A[9]); p1.y = cvtpk(A[10], A[11]); p1.z = cvtpk(A[12], A[13]); p1.w = cvtpk(A[14], A[15]);
                        const bf16x8 pa0 = __builtin_bit_cast(bf16x8, p0), pa1 = __builtin_bit_cast(bf16x8, p1);
                        LAS unsigned char* vp = Vl + (32 * st + 4 * h + tq) * RS + (16 * blk + 4 * tp) * 2;
#pragma unroll
                        for (int d = 0; d < 4; ++d) {
                            const v4i16_t a0 = vtr(vp + d * 64), a1 = vtr(vp + 8 * RS + d * 64), b0 = vtr(vp + 16 * RS + d * 64), b1 = vtr(vp + 24 * RS + d * 64);
                            const bf16x8 vb0 = __builtin_shufflevector(a0, a1, 0, 1, 2, 3, 4, 5, 6, 7), vb1 = __builtin_shufflevector(b0, b1, 0, 1, 2, 3, 4, 5, 6, 7);
                            o[d] = __builtin_amdgcn_mfma_f32_32x32x16_bf16(pa0, vb0, o[d], 0, 0, 0);
                            o[d] = __builtin_amdgcn_mfma_f32_32x32x16_bf16(pa1, vb1, o[d], 0, 0, 0); }
                    }
                }
            }
            bf16_t* gp0 = SG + ((size_t)b * SEQ + q0 + 4 * h) * 1024 + hh * 128 + r32;
#pragma unroll
            for (int d = 0; d < 4; ++d) {
#pragma unroll
                for (int i = 0; i < 16; ++i) { bf16_t* gp = gp0 + ((i & 3) + 8 * (i >> 2)) * 1024 + 32 * d;
                    *gp = (bf16_t)f2bf(o[d][i] * bf2f(*gp)); }
                __builtin_amdgcn_sched_barrier(0); }
        }
    }
}

__device__ __forceinline__ bf16x8 cat44(v4i16_t lo, v4i16_t hi) { return __builtin_shufflevector(lo, hi, 0, 1, 2, 3, 4, 5, 6, 7); }
constexpr size_t WS_DL = 26 * MiB;
__device__ __forceinline__ void gla_pre(const Args& a, LAS unsigned char* lds, int item, int tid, int lane, int wave) {
    bf16_t* GQK = (bf16_t*)(a.ws + WS_ACT + B_GQK * ACT_STRIDE); const float* grank = (const float*)(a.ws + WS_RANK);
    bf16_t* ATT = (bf16_t*)a.out + (size_t)M * 1024 + (size_t)item * 4096; float* DLg = (float*)(a.ws + WS_DL) + (size_t)item * 128;
    constexpr int RS = 272;
    LAS unsigned char* QE = lds; LAS unsigned char* KE = QE + 64 * RS; LAS unsigned char* KD = KE + 64 * RS; LAS float* GR = (LAS float*)(KD + 64 * RS); LAS float* TOT = GR + 64 * 16;
    const int b = item >> 7, hd = (item >> 5) & 3, ch = item & 31;
    const int h = lane >> 5, r32 = lane & 31;
    const int pd = tid & 127, jg = tid >> 7;
    const size_t rowb = (size_t)b * SEQ + 64 * ch;
    float wu[16];
#pragma unroll
    for (int r = 0; r < 16; ++r) wu[r] = a.w_dec_up[r * 512 + hd * 128 + pd];
    const float bd = a.b_dec[hd * 128 + pd];
    if (tid < 256) *(LAS f32x4*)(GR + tid * 4) = *(const f32x4*)(grank + rowb * 16 + tid * 4);
    { const int row = tid >> 3, seg = tid & 7; const bf16_t* gq = GQK + (rowb + row) * 1024 + hd * 128 + seg * 16;
      LAS u32x4* dq = (LAS u32x4*)(QE + row * RS + seg * 32); LAS u32x4* dk = (LAS u32x4*)(KD + row * RS + seg * 32);
      dq[0] = ((const u32x4*)gq)[0]; dq[1] = ((const u32x4*)gq)[1]; dk[0] = ((const u32x4*)(gq + 512))[0]; dk[1] = ((const u32x4*)(gq + 512))[1]; }
    __syncthreads();
    float cum[16];
    { float run = 0.f;
#pragma unroll
      for (int u = 0; u < 16; ++u) { const LAS f32x4* g4 = (const LAS f32x4*)(GR + (16 * jg + u) * 16); float z = bd;
#pragma unroll
          for (int r4 = 0; r4 < 4; ++r4) { const f32x4 g = g4[r4]; z += g.x * wu[4 * r4] + g.y * wu[4 * r4 + 1] + g.z * wu[4 * r4 + 2] + g.w * wu[4 * r4 + 3]; }
          const float la = (fminf(z, 0.f) - __logf(1.f + __expf(-fabsf(z)))) * (1.f / 16.f); run += la; cum[u] = run; }
      TOT[jg * 128 + pd] = run; }
    __syncthreads();
    { const float t0s = TOT[pd], t1s = TOT[128 + pd], t2s = TOT[256 + pd], t3s = TOT[384 + pd];
      const float off = jg == 0 ? 0.f : (jg == 1 ? t0s : (jg == 2 ? t0s + t1s : t0s + t1s + t2s)); const float blast = (t0s + t1s) + (t2s + t3s);
      const float dlv = __expf(blast);
      if (jg == 0) DLg[pd] = dlv;
#pragma unroll
      for (int u = 0; u < 16; ++u) { const float bc = off + cum[u]; const int t = 16 * jg + u;
          const float q = bf2f(*(const LAS bf16_t*)(QE + t * RS + pd * 2)), k = bf2f(*(const LAS bf16_t*)(KD + t * RS + pd * 2));
          const float eb = __expf(bc), ke = k * __builtin_amdgcn_rcpf(eb);
          *(LAS bf16_t*)(QE + t * RS + pd * 2) = (bf16_t)f2bf(q * eb * 0.08838834764831845f);
          *(LAS bf16_t*)(KE + t * RS + pd * 2) = (bf16_t)f2bf(ke);
          *(LAS bf16_t*)(KD + t * RS + pd * 2) = (bf16_t)f2bf(ke * dlv); } }
    __syncthreads();
    if (wave < 3) { const int it = wave == 0 ? 0 : 1, jt = wave == 2 ? 1 : 0;
        f32x16 z;
#pragma unroll
        for (int i = 0; i < 16; ++i) z[i] = 0.f;
#pragma unroll
        for (int s = 0; s < 8; ++s) { const bf16x8 af = *(const LAS bf16x8*)(QE + (32 * it + r32) * RS + (16 * s + 8 * h) * 2), bfr = *(const LAS bf16x8*)(KE + (32 * jt + r32) * RS + (16 * s + 8 * h) * 2);
            z = __builtin_amdgcn_mfma_f32_32x32x16_bf16(af, bfr, z, 0, 0, 0); }
#pragma unroll
        for (int i = 0; i < 16; ++i) { const int ir = 32 * it + (i & 3) + 8 * (i >> 2) + 4 * h, jc = 32 * jt + r32;
            ATT[ir * 64 + jc] = (bf16_t)f2bf(jc <= ir ? z[i] : 0.f); } }
    { const int row = tid >> 3, seg = tid & 7; bf16_t* gq = GQK + (rowb + row) * 1024 + hd * 128 + seg * 16;
      const LAS u32x4* sq = (const LAS u32x4*)(QE + row * RS + seg * 32); const LAS u32x4* sk = (const LAS u32x4*)(KD + row * RS + seg * 32);
      ((u32x4*)gq)[0] = sq[0]; ((u32x4*)gq)[1] = sq[1]; ((u32x4*)(gq + 512))[0] = sk[0]; ((u32x4*)(gq + 512))[1] = sk[1]; }
    __syncthreads();
}
constexpr size_t WS_SA = 27 * MiB;
constexpr size_t WS_DCUM = 31 * MiB;
__device__ __forceinline__ void gla_norm_store(LAS unsigned char* OB, LAS float* NG, bf16_t* GG, size_t rowp, int hd, int tid, u32x4 rg0, u32x4 rg1, u32x4 rg2, u32x4 rg3) {
    constexpr int VS = 528;
    const int row = tid >> 3, part = tid & 7; const LAS u32x4* src = (const LAS u32x4*)(OB + row * VS + part * 64);
    u32x4 w[4]; float ss = 0.f;
#pragma unroll
    for (int c = 0; c < 4; ++c) { w[c] = src[c]; const float e0 = bflo(w[c].x), e1 = bfhi(w[c].x), e2 = bflo(w[c].y), e3 = bfhi(w[c].y), e4 = bflo(w[c].z), e5 = bfhi(w[c].z), e6 = bflo(w[c].w), e7 = bfhi(w[c].w);
        ss += (e0 * e0 + e1 * e1) + (e2 * e2 + e3 * e3) + (e4 * e4 + e5 * e5) + (e6 * e6 + e7 * e7); }
    ss += __shfl_xor(ss, 1); ss += __shfl_xor(ss, 2); ss += __shfl_xor(ss, 4);
    const float rstd = 1.f / sqrtf(ss * (1.f / 256.f) + EPS);
    u32x4* gp = (u32x4*)(GG + (rowp + row) * 1024 + hd * 256 + part * 32); const LAS f32x4* ng = (const LAS f32x4*)(NG + part * 32);
#pragma unroll
    for (int c = 0; c < 4; ++c) { const u32x4 gt = c == 0 ? rg0 : (c == 1 ? rg1 : (c == 2 ? rg2 : rg3)); const f32x4 n0 = ng[2 * c], n1 = ng[2 * c + 1]; u32x4 r;
        r.x = pk2(bflo(w[c].x) * rstd * n0.x * bflo(gt.x), bfhi(w[c].x) * rstd * n0.y * bfhi(gt.x)); r.y = pk2(bflo(w[c].y) * rstd * n0.z * bflo(gt.y), bfhi(w[c].y) * rstd * n0.w * bfhi(gt.y));
        r.z = pk2(bflo(w[c].z) * rstd * n1.x * bflo(gt.z), bfhi(w[c].z) * rstd * n1.y * bfhi(gt.z)); r.w = pk2(bflo(w[c].w) * rstd * n1.z * bflo(gt.w), bfhi(w[c].w) * rstd * n1.w * bfhi(gt.w));
        gp[c] = r; }
}
__device__ __forceinline__ void gla_raw_store(LAS unsigned char* OB, bf16_t* GV, size_t rowp, int hd, int tid) {
    constexpr int VS = 528;
    const int row = tid >> 3, part = tid & 7; const LAS u32x4* src = (const LAS u32x4*)(OB + row * VS + part * 64);
    u32x4* gp = (u32x4*)(GV + (rowp + row) * 1024 + hd * 256 + part * 32);
    gp[0] = src[0]; gp[1] = src[1]; gp[2] = src[2]; gp[3] = src[3];
}
template <int half> __device__ __forceinline__ void gla_serial(const Args& a, LAS unsigned char* lds, int item, int tid, int lane, int wave) {
    const bf16_t* GQK = (const bf16_t*)(a.ws + WS_ACT + B_GQK * ACT_STRIDE); bf16_t* GV = (bf16_t*)(a.ws + WS_ACT + B_GV * ACT_STRIDE);
    bf16_t* GG = (bf16_t*)(a.ws + WS_ACT + B_GG * ACT_STRIDE);
    const bf16_t* ATT = (const bf16_t*)a.out + (size_t)M * 1024 + (size_t)item * 32 * 4096; const float* DLg = (const float*)(a.ws + WS_DL) + (size_t)item * 32 * 128;
    float* DCUM = (float*)(a.ws + WS_DCUM) + (size_t)item * 16 * 128;
    constexpr int RS = 272, VS = 528, AS = 144;
    LAS unsigned char* QE = lds; LAS unsigned char* KD = QE + 64 * RS; LAS unsigned char* VL = KD + 64 * RS; LAS unsigned char* AT = VL + 64 * VS; LAS float* DL = (LAS float*)(AT + 64 * AS); LAS unsigned char* OB = (LAS unsigned char*)(DL + 128); LAS float* NG = (LAS float*)(OB + 64 * VS);
    const int b = item >> 2, hd = item & 3, c0 = 16 * half;
    const int h = lane >> 5, r32 = lane & 31, i16 = lane & 15, tq = i16 >> 2, tp = i16 & 3, blk = (lane >> 4) & 1;
    const int lrow = tid >> 3, lseg = tid & 7;
    f32x16 S[4];
#pragma unroll
    for (int d = 0; d < 4; ++d)
#pragma unroll
        for (int i = 0; i < 16; ++i) S[d][i] = 0.f;
    u32x4 rq0, rq1, rk0, rk1, rv0, rv1, rv2, rv3, ra, rg0, rg1, rg2, rg3; f32x4 rd = {0.f, 0.f, 0.f, 0.f};
    float dcum = 1.f;
    if (tid < 64) *(LAS f32x4*)(NG + tid * 4) = *(const f32x4*)(a.gla_norm_g + tid * 4);
    rg0 = rg1 = rg2 = rg3 = (u32x4){0u, 0u, 0u, 0u};
#define GLA_FETCH(ch) do { const size_t rowg = (size_t)b * SEQ + 64 * (ch) + lrow; const u32x4* pq = (const u32x4*)(GQK + rowg * 1024 + hd * 128 + lseg * 16); \
        rq0 = pq[0]; rq1 = pq[1]; const u32x4* pk = (const u32x4*)(GQK + rowg * 1024 + 512 + hd * 128 + lseg * 16); rk0 = pk[0]; rk1 = pk[1]; \
        const u32x4* pv = (const u32x4*)(GV + rowg * 1024 + hd * 256 + lseg * 32); rv0 = pv[0]; rv1 = pv[1]; rv2 = pv[2]; rv3 = pv[3]; \
        ra = *(const u32x4*)(ATT + (size_t)(ch) * 4096 + lrow * 64 + lseg * 8); if (tid < 32) rd = *(const f32x4*)(DLg + (size_t)(ch) * 128 + tid * 4); } while (0)
#define GLA_GATE(ch) do { const u32x4* pg = (const u32x4*)(GG + ((size_t)b * SEQ + 64 * (ch) + lrow) * 1024 + hd * 256 + lseg * 32); rg0 = pg[0]; rg1 = pg[1]; rg2 = pg[2]; rg3 = pg[3]; } while (0)
    GLA_FETCH(c0);
#pragma unroll 1
    for (int ch = c0; ch < c0 + 16; ++ch) {
        const size_t rowb = (size_t)b * SEQ + 64 * ch;
        __syncthreads();
        { LAS u32x4* dq = (LAS u32x4*)(QE + lrow * RS + lseg * 32); dq[0] = rq0; dq[1] = rq1; LAS u32x4* dk = (LAS u32x4*)(KD + lrow * RS + lseg * 32); dk[0] = rk0; dk[1] = rk1;
          LAS u32x4* dv = (LAS u32x4*)(VL + lrow * VS + lseg * 64); dv[0] = rv0; dv[1] = rv1; dv[2] = rv2; dv[3] = rv3;
          *(LAS u32x4*)(AT + lrow * AS + lseg * 16) = ra; if (tid < 32) *(LAS f32x4*)(DL + tid * 4) = rd; }
        if (ch > c0) { if constexpr (half == 0) gla_norm_store(OB, NG, GG, rowb - 64, hd, tid, rg0, rg1, rg2, rg3); else gla_raw_store(OB, GV, rowb - 64, hd, tid); }
        __syncthreads();
        if (ch + 1 < c0 + 16) GLA_FETCH(ch + 1);
        if constexpr (half == 0) { GLA_GATE(ch); }
        else { if (tid < 128) { DCUM[(ch - 16) * 128 + tid] = dcum; dcum *= DL[tid]; } }
        bf16x8 vf[4];
        { LAS unsigned char* vp = VL + (8 * h + tq) * VS + (32 * wave + 16 * blk + 4 * tp) * 2;
#pragma unroll
          for (int s = 0; s < 4; ++s) vf[s] = cat44(vtr(vp + 16 * s * VS), vtr(vp + (16 * s + 4) * VS)); }
        f32x16 o[2];
#pragma unroll
        for (int it = 0; it < 2; ++it) {
#pragma unroll
            for (int i = 0; i < 16; ++i) o[it][i] = 0.f;
#pragma unroll
            for (int s = 0; s < 4; ++s) if (s < 2 * (it + 1)) { const bf16x8 af = *(const LAS bf16x8*)(AT + (32 * it + r32) * AS + (16 * s + 8 * h) * 2); o[it] = __builtin_amdgcn_mfma_f32_32x32x16_bf16(af, vf[s], o[it], 0, 0, 0); }
        }
#pragma unroll
        for (int dt = 0; dt < 4; ++dt)
#pragma unroll
            for (int s = 0; s < 2; ++s) { u32x4 p; p.x = cvtpk(S[dt][8 * s], S[dt][8 * s + 1]); p.y = cvtpk(S[dt][8 * s + 2], S[dt][8 * s + 3]); p.z = cvtpk(S[dt][8 * s + 4], S[dt][8 * s + 5]); p.w = cvtpk(S[dt][8 * s + 6], S[dt][8 * s + 7]);
                const bf16x8 sb = __builtin_bit_cast(bf16x8, p);
#pragma unroll
                for (int it = 0; it < 2; ++it) { LAS unsigned char* qa = QE + (32 * it + r32) * RS + (32 * dt + 16 * s + 4 * h) * 2;
                    const v4i16_t lo = *(const LAS v4i16_t*)qa, hi = *(const LAS v4i16_t*)(qa + 16);
                    o[it] = __builtin_amdgcn_mfma_f32_32x32x16_bf16(cat44(lo, hi), sb, o[it], 0, 0, 0); } }
#pragma unroll
        for (int dt = 0; dt < 4; ++dt) {
#pragma unroll
            for (int g = 0; g < 4; ++g) { const f32x4 dl4 = *(const LAS f32x4*)(DL + 32 * dt + 8 * g + 4 * h); S[dt][4 * g] *= dl4.x; S[dt][4 * g + 1] *= dl4.y; S[dt][4 * g + 2] *= dl4.z; S[dt][4 * g + 3] *= dl4.w; }
            LAS unsigned char* kp = KD + (8 * h + tq) * RS + (32 * dt + 16 * blk + 4 * tp) * 2;
#pragma unroll
            for (int s = 0; s < 4; ++s) { const bf16x8 af = cat44(vtr(kp + 16 * s * RS), vtr(kp + (16 * s + 4) * RS)); S[dt] = __builtin_amdgcn_mfma_f32_32x32x16_bf16(af, vf[s], S[dt], 0, 0, 0); } }
#pragma unroll
        for (int it = 0; it < 2; ++it)
#pragma unroll
            for (int i = 0; i < 16; ++i) *(LAS bf16_t*)(OB + (32 * it + (i & 3) + 8 * (i >> 2) + 4 * h) * VS + (32 * wave + r32) * 2) = (bf16_t)f2bf(o[it][i]);
    }
    __syncthreads();
    { const size_t rowp = (size_t)b * SEQ + 64 * (c0 + 15);
      if constexpr (half == 0) gla_norm_store(OB, NG, GG, rowp, hd, tid, rg0, rg1, rg2, rg3); else gla_raw_store(OB, GV, rowp, hd, tid); }
    if constexpr (half == 0) { unsigned* SAp = (unsigned*)(a.ws + WS_SA) + ((size_t)item * 8 + wave) * 2048;
#pragma unroll
        for (int dt = 0; dt < 4; ++dt)
#pragma unroll
            for (int j = 0; j < 8; ++j) SAp[(dt * 8 + j) * 64 + lane] = cvtpk(S[dt][2 * j], S[dt][2 * j + 1]); }
#undef GLA_FETCH
#undef GLA_GATE
}
__device__ __forceinline__ void gla_fix(const Args& a, LAS unsigned char* lds, int pitem, int tid, int lane, int wave) {
    const bf16_t* GQK = (const bf16_t*)(a.ws + WS_ACT + B_GQK * ACT_STRIDE); const bf16_t* GV = (const bf16_t*)(a.ws + WS_ACT + B_GV * ACT_STRIDE);
    bf16_t* GG = (bf16_t*)(a.ws + WS_ACT + B_GG * ACT_STRIDE);
    constexpr int RS = 272, VS = 528;
    LAS unsigned char* QE = lds; LAS unsigned char* OB = QE + 64 * RS; LAS float* DL = (LAS float*)(OB + 64 * VS); LAS float* NG = DL + 128;
    const int psw = (pitem & 7) * 32 + (pitem >> 3);
    const int item = psw >> 3, b = item >> 2, hd = item & 3;
    const int h = lane >> 5, r32 = lane & 31, lrow = tid >> 3, lseg = tid & 7;
    unsigned Sp[4][8];
    { const unsigned* SAp = (const unsigned*)(a.ws + WS_SA) + ((size_t)item * 8 + wave) * 2048;
#pragma unroll
      for (int dt = 0; dt < 4; ++dt)
#pragma unroll
          for (int j = 0; j < 8; ++j) Sp[dt][j] = SAp[(dt * 8 + j) * 64 + lane]; }
    if (tid < 64) *(LAS f32x4*)(NG + tid * 4) = *(const f32x4*)(a.gla_norm_g + tid * 4);
#pragma unroll 1
    for (int k = 0; k < 2; ++k) {
        const int cc = 2 * (psw & 7) + k;
        const size_t rowb = (size_t)b * SEQ + 64 * (16 + cc);
        { const u32x4* pq = (const u32x4*)(GQK + (rowb + lrow) * 1024 + hd * 128 + lseg * 16); LAS u32x4* dq = (LAS u32x4*)(QE + lrow * RS + lseg * 32); dq[0] = pq[0]; dq[1] = pq[1];
          const u32x4* po = (const u32x4*)(GV + (rowb + lrow) * 1024 + hd * 256 + lseg * 32); LAS u32x4* dob = (LAS u32x4*)(OB + lrow * VS + lseg * 64); dob[0] = po[0]; dob[1] = po[1]; dob[2] = po[2]; dob[3] = po[3];
          if (tid < 32) *(LAS f32x4*)(DL + tid * 4) = *(const f32x4*)((const float*)(a.ws + WS_DCUM) + ((size_t)item * 16 + cc) * 128 + tid * 4); }
        const u32x4* pg = (const u32x4*)(GG + (rowb + lrow) * 1024 + hd * 256 + lseg * 32); const u32x4 rg0 = pg[0], rg1 = pg[1], rg2 = pg[2], rg3 = pg[3];
        __syncthreads();
        f32x16 o[2];
#pragma unroll
        for (int it = 0; it < 2; ++it)
#pragma unroll
            for (int i = 0; i < 16; ++i) o[it][i] = 0.f;
#pragma unroll
        for (int dt = 0; dt < 4; ++dt)
#pragma unroll
            for (int s2 = 0; s2 < 2; ++s2) { const f32x4 dA = *(const LAS f32x4*)(DL + 32 * dt + 16 * s2 + 4 * h), dB = *(const LAS f32x4*)(DL + 32 * dt + 16 * s2 + 8 + 4 * h);
                const unsigned w0 = Sp[dt][4 * s2], w1 = Sp[dt][4 * s2 + 1], w2 = Sp[dt][4 * s2 + 2], w3 = Sp[dt][4 * s2 + 3];
                u32x4 p; p.x = cvtpk(bflo(w0) * dA.x, bfhi(w0) * dA.y); p.y = cvtpk(bflo(w1) * dA.z, bfhi(w1) * dA.w);
                p.z = cvtpk(bflo(w2) * dB.x, bfhi(w2) * dB.y); p.w = cvtpk(bflo(w3) * dB.z, bfhi(w3) * dB.w);
                const bf16x8 sb = __builtin_bit_cast(bf16x8, p);
#pragma unroll
                for (int it = 0; it < 2; ++it) { LAS unsigned char* qa = QE + (32 * it + r32) * RS + (32 * dt + 16 * s2 + 4 * h) * 2;
                    const v4i16_t lo = *(const LAS v4i16_t*)qa, hi = *(const LAS v4i16_t*)(qa + 16);
                    o[it] = __builtin_amdgcn_mfma_f32_32x32x16_bf16(cat44(lo, hi), sb, o[it], 0, 0, 0); } }
#pragma unroll
        for (int it = 0; it < 2; ++it)
#pragma unroll
            for (int i = 0; i < 16; ++i) { LAS bf16_t* op = (LAS bf16_t*)(OB + (32 * it + (i & 3) + 8 * (i >> 2) + 4 * h) * VS + (32 * wave + r32) * 2); *op = (bf16_t)f2bf(o[it][i] + bf2f(*op)); }
        __syncthreads();
        gla_norm_store(OB, NG, GG, rowb, hd, tid, rg0, rg1, rg2, rg3);
        __syncthreads();
    }
}

__device__ __forceinline__ void final_norm(const Args& a, int gw, int NGW, int lane) {
    const bf16_t* PRE = (const bf16_t*)(a.ws + WS_ACT + B_GQK * ACT_STRIDE);
    const f32x4* g = (const f32x4*)a.final_g;
    const f32x4 g0 = g[2 * lane], g1 = g[2 * lane + 1], g2 = g[128 + 2 * lane], g3 = g[128 + 2 * lane + 1];
    u32x4 nw0, nw1; f32x4 nx0, nx1, nx2, nx3;
#define FN_LOAD(m_) do { const u32x4* pr = (const u32x4*)(PRE + (size_t)(m_) * D) + lane; const f32x4* xr = (const f32x4*)(a.x + (size_t)(m_) * D) + 2 * lane; \
        nw0 = __builtin_nontemporal_load(pr); nw1 = __builtin_nontemporal_load(pr + 64); nx0 = __builtin_nontemporal_load(xr); nx1 = __builtin_nontemporal_load(xr + 1); nx2 = __builtin_nontemporal_load(xr + 128); nx3 = __builtin_nontemporal_load(xr + 129); } while (0)
    if (gw < M) FN_LOAD(gw);
    for (int m = gw; m < M; m += NGW) {
        f32x4 v[4];
        v[0] = nx0 + (f32x4){bflo(nw0.x), bfhi(nw0.x), bflo(nw0.y), bfhi(nw0.y)}; v[1] = nx1 + (f32x4){bflo(nw0.z), bfhi(nw0.z), bflo(nw0.w), bfhi(nw0.w)};
        v[2] = nx2 + (f32x4){bflo(nw1.x), bfhi(nw1.x), bflo(nw1.y), bfhi(nw1.y)}; v[3] = nx3 + (f32x4){bflo(nw1.z), bfhi(nw1.z), bflo(nw1.w), bfhi(nw1.w)};
        if (m + NGW < M) FN_LOAD(m + NGW);
        float s2 = 0.f;
#pragma unroll
        for (int j = 0; j < 4; ++j) s2 += (v[j].x * v[j].x + v[j].y * v[j].y) + (v[j].z * v[j].z + v[j].w * v[j].w);
        const float rstd = 1.f / sqrtf(wave_sum(s2) * (1.f / D) + EPS);
        f32x4* o = (f32x4*)(a.out + (size_t)m * D) + 2 * lane;
        __builtin_nontemporal_store(v[0] * rstd * g0, o); __builtin_nontemporal_store(v[1] * rstd * g1, o + 1); __builtin_nontemporal_store(v[2] * rstd * g2, o + 128); __builtin_nontemporal_store(v[3] * rstd * g3, o + 129);
    }
#undef FN_LOAD
}

#define XB_TMO      128
#define XB_XCNT(j)  (256  + 64 * (j))
#define XB_XSUB(j)  (1280 + 64 * (j))
#define XB_XGEN(j)  (2304 + 64 * (j))
#define XB_TOP      3328
#define XB_TOPGEN   3392
#define XCD_BAR_WORDS 3456
#define XB_SPIN_CAP (1u << 18)

__device__ __forceinline__ unsigned xb_ld(unsigned* p)              { return __hip_atomic_load(p, __ATOMIC_RELAXED, __HIP_MEMORY_SCOPE_AGENT); }
__device__ __forceinline__ unsigned xb_add(unsigned* p, unsigned v) { return __hip_atomic_fetch_add(p, v, __ATOMIC_RELAXED, __HIP_MEMORY_SCOPE_AGENT); }
__device__ __forceinline__ unsigned xb_xcc_id() { return (unsigned)__builtin_amdgcn_s_getreg((3 << 11) | 20) & 0xFu; }
#define XB_SPIN(cond, bar) do { unsigned _sp = 0; while (cond) { __builtin_amdgcn_s_sleep(1); \
    if ((++_sp & 255u) == 0u) { if (xb_ld(&(bar)[XB_TMO])) break; if (_sp > XB_SPIN_CAP) { atomicAdd(&(bar)[XB_TMO], 1u); break; } } } } while (0)

struct XcdBarrier {
    unsigned* bar; unsigned x;
    volatile LAS unsigned* st;
};

__device__ __forceinline__ XcdBarrier xcd_barrier_post(unsigned* bar, volatile LAS unsigned* st) {
    XcdBarrier b; b.bar = bar; b.x = xb_xcc_id(); b.st = st;
    if (threadIdx.x == 0) (void)xb_add(&bar[XB_XCNT(b.x)], 1u);
    return b;
}
__device__ __forceinline__ void xcd_barrier_complete(unsigned* bar, unsigned x, unsigned& nloc, unsigned& nx) {
    const unsigned G = gridDim.x * gridDim.y * gridDim.z;
    unsigned sum, cnt, mine, sp = 0u;
    for (;;) {
        sum = 0u; cnt = 0u; mine = 0u;
#pragma unroll
        for (unsigned j = 0; j < 16; ++j) { const unsigned c = xb_ld(&bar[XB_XCNT(j)]); sum += c; cnt += (c > 0u) ? 1u : 0u; mine = (j == x) ? c : mine; }
        if (sum == G) break;
        __builtin_amdgcn_s_sleep(1);
        if ((++sp & 255u) == 0u) { if (xb_ld(&bar[XB_TMO])) break; if (sp > XB_SPIN_CAP) { atomicAdd(&bar[XB_TMO], 1u); break; } }
    }
    nloc = mine > 0u ? mine : 1u; nx = cnt > 0u ? cnt : 1u;
}

__device__ __forceinline__ void xcd_barrier(const XcdBarrier& b) {
    asm volatile("s_waitcnt vmcnt(0)" ::: "memory");
    __syncthreads();
    if (threadIdx.x == 0) {
        unsigned* bar = b.bar;
        __builtin_amdgcn_s_waitcnt(0);
        unsigned nloc = b.st[0], nx = b.st[1];
        if (nloc == 0u) { xcd_barrier_complete(bar, b.x, nloc, nx); b.st[0] = nloc; b.st[1] = nx; }
        const unsigned old = xb_add(&bar[XB_XSUB(b.x)], 1u);
        const unsigned gen = old / nloc;
        if (old + 1u == (gen + 1u) * nloc) {
            __builtin_amdgcn_fence(__ATOMIC_RELEASE, "agent");
            asm volatile("s_waitcnt vmcnt(0)" ::: "memory");
            const unsigned og = xb_add(&bar[XB_TOP], 1u);
            const unsigned tg = og / nx;
            if (og + 1u == (tg + 1u) * nx) xb_add(&bar[XB_TOPGEN], 1u);
            else XB_SPIN(xb_ld(&bar[XB_TOPGEN]) == tg, bar);
            __builtin_amdgcn_fence(__ATOMIC_ACQUIRE, "agent");
            xb_add(&bar[XB_XGEN(b.x)], 1u);
            asm volatile("s_waitcnt vmcnt(0)" ::: "memory");
        } else {
            XB_SPIN(xb_ld(&bar[XB_XGEN(b.x)]) == gen, bar);
            __builtin_amdgcn_fence(__ATOMIC_ACQUIRE, "agent");
            asm volatile("s_waitcnt vmcnt(0)" ::: "memory");
        }
    }
    __syncthreads();
}

#define GRID_SYNC() do { asm volatile("s_waitcnt vmcnt(0) lgkmcnt(0)" ::: "memory"); __syncthreads(); if (wave == 0) { __builtin_amdgcn_fence(__ATOMIC_RELEASE, "agent"); asm volatile("s_waitcnt vmcnt(0)" ::: "memory"); } grid.sync(); __builtin_amdgcn_fence(__ATOMIC_ACQUIRE, "agent"); asm volatile("s_waitcnt vmcnt(0)" ::: "memory"); } while (0)
#define XCD_SYNC() do { xcd_barrier(xbar); } while (0)
#define XB_EXIT 3520
__device__ unsigned g_bar_words[4096];
__global__ void __launch_bounds__(NTHREADS, 2) fwd_megakernel(Args a) {
    extern __shared__ __attribute__((aligned(16))) unsigned char lds_raw[];
    LAS unsigned char* lds = (LAS unsigned char*)lds_raw;
    cg::grid_group grid = cg::this_grid();
    const int tid = threadIdx.x, lane = tid & 63, wave = __builtin_amdgcn_readfirstlane(tid >> 6);
    const int G = gridDim.x, gw = blockIdx.x * NWAVES + wave, NGW = G * NWAVES;
    unsigned char* ws = a.ws;
    volatile LAS unsigned* xst = (volatile LAS unsigned*)(lds + 131072 + 256);
    if (tid < 2) xst[tid] = 0u;
    __syncthreads();
    const XcdBarrier xbar = xcd_barrier_post(g_bar_words, xst);
    const char* H = (const char*)a.out;
    const char* WIN = (const char*)(ws + WS_WIN); const char* WPAB = (const char*)(ws + WS_WPAB); const char* WO = (const char*)(ws + WS_WO);
    bf16_t* ACT = (bf16_t*)(ws + WS_ACT);

    p0_prologue(a, lds, gw, NGW, wave, lane, tid);
    if (G == 0x7fffffff) GRID_SYNC();
    XCD_SYNC();

    {
        pg8::Sched S{}; S.nM = M / 256; S.nN = N1 / 256; S.nwg = S.nM * S.nN; S.G = G; S.c = blockIdx.x; S.reps = 1;
        S.A0 = S.A1 = S.A2 = S.A3 = H; S.B0 = S.B1 = S.B2 = S.B3 = WIN;
        pg8::EpiProj E{ACT};
        pg8::gemm_phase<pg8::EpiProj>(lds, S, E);
    }
    XCD_SYNC();

    for (int it = blockIdx.x; it < 1024; it += G) gla_pre(a, lds, it, tid, lane, wave);
    sb_mfma(a, lds, tid, lane, wave);
    XCD_SYNC();

    if (blockIdx.x < 64) { if (blockIdx.x & 1) gla_serial<1>(a, lds, blockIdx.x >> 1, tid, lane, wave); else gla_serial<0>(a, lds, blockIdx.x >> 1, tid, lane, wave); }
    else {
        pg8::Sched S{}; S.nM = M / 256; S.nN = 12; S.nwg = S.nM * S.nN; S.G = G - 64; S.c = blockIdx.x - 64; S.reps = 1; S.split = 8;
        S.A0 = S.A2 = S.A3 = H; S.A1 = (const char*)(ACT + (size_t)B_SG * (ACT_STRIDE / 2));
        S.B0 = S.B2 = S.B3 = WIN + (size_t)N1 * 2048; S.B1 = WPAB + (size_t)1024 * 2048;
        pg8::EpiGateYb E{pg8::EpiGate{(unsigned char*)(ACT + (size_t)B_SQ * (ACT_STRIDE / 2)), (unsigned char*)(ACT + (size_t)B_SK * (ACT_STRIDE / 2)), a.b_gate}, pg8::EpiRaw{ACT + (size_t)B_SV * (ACT_STRIDE / 2)}};
        pg8::gemm_phase<pg8::EpiGateYb>(lds, S, E);
    }
    XCD_SYNC();
    for (int it = blockIdx.x; it < 256; it += G) gla_fix(a, lds, it, tid, lane, wave);
    XCD_SYNC();
    {
        pg8::Sched S{}; S.nM = M / 256; S.nN = 4; S.nwg = S.nM * S.nN; S.G = G; S.c = blockIdx.x; S.reps = 1;
        S.A0 = S.A1 = S.A2 = S.A3 = (const char*)(ACT + (size_t)B_GG * (ACT_STRIDE / 2));
        S.B0 = S.B1 = S.B2 = S.B3 = WPAB;
        pg8::EpiMerge E{(const unsigned char*)(ACT + (size_t)B_SQ * (ACT_STRIDE / 2)), (const unsigned char*)(ACT + (size_t)B_SK * (ACT_STRIDE / 2)), ACT + (size_t)B_SV * (ACT_STRIDE / 2)};
        pg8::gemm_phase<pg8::EpiMerge>(lds, S, E);
    }
    XCD_SYNC();

    {
        pg8::Sched S{}; S.nM = M / 256; S.nN = 4; S.nwg = S.nM * S.nN; S.G = G; S.c = blockIdx.x; S.reps = 1;
        S.A0 = S.A1 = S.A2 = S.A3 = (const char*)(ACT + (size_t)B_SV * (ACT_STRIDE / 2)); S.B0 = S.B1 = S.B2 = S.B3 = WO;
        pg8::EpiRaw E{ACT + (size_t)B_GQK * (ACT_STRIDE / 2)};
        pg8::gemm_phase<pg8::EpiRaw>(lds, S, E);
    }
    XCD_SYNC();

    final_norm(a, gw, NGW, lane);
    if (tid == 0) { const unsigned old = __hip_atomic_fetch_add(g_bar_words + XB_EXIT, 1u, __ATOMIC_RELAXED, __HIP_MEMORY_SCOPE_AGENT); xst[0] = (old == (unsigned)G - 1u) ? 1u : 0u; }
    __syncthreads();
    if (xst[0] != 0u) { for (int i = tid; i < 4096; i += NTHREADS) __hip_atomic_store(g_bar_words + i, 0u, __ATOMIC_RELAXED, __HIP_MEMORY_SCOPE_AGENT); }
}

extern "C" void kernel_launch(void* const* d_in, const int* in_sizes, int n_in, void* d_out, int out_size, void* d_ws, size_t ws_size, hipStream_t stream) {
    static int grid = 0;
    if (grid == 0) {
        int dev = 0, cus = 0, per_cu = 0;
        hipGetDevice(&dev);
        hipDeviceGetAttribute(&cus, hipDeviceAttributeMultiprocessorCount, dev);
        if (hipFuncSetAttribute((const void*)fwd_megakernel, hipFuncAttributeMaxDynamicSharedMemorySize, LDS_BYTES) != hipSuccess) fprintf(stderr, "kernel_launch: hipFuncSetAttribute failed\n");
        if (hipOccupancyMaxActiveBlocksPerMultiprocessor(&per_cu, (const void*)fwd_megakernel, NTHREADS, LDS_BYTES) != hipSuccess || per_cu < 1) { fprintf(stderr, "kernel_launch: occupancy query says %d\n", per_cu); per_cu = 1; }
        (void)hipGetLastError();
        grid = cus * per_cu;
        if (ws_size < 256 * MiB) fprintf(stderr, "kernel_launch: workspace too small: %zu\n", ws_size);
    }
    Args a{};
    a.x = (const float*)d_in[0]; a.norm_g = (const float*)d_in[1]; a.w_in = (const float*)d_in[2]; a.w_dec_up = (const float*)d_in[3]; a.b_dec = (const float*)d_in[4];
    a.gla_norm_g = (const float*)d_in[5]; a.w_pa = (const float*)d_in[6]; a.w_pb = (const float*)d_in[7]; a.b_gate = (const float*)d_in[8]; a.w_o = (const float*)d_in[9];
    a.final_g = (const float*)d_in[10]; a.out = (float*)d_out; a.ws = (unsigned char*)d_ws;
    void* args[] = {&a};
    hipError_t e = hipLaunchCooperativeKernel((const void*)fwd_megakernel, dim3(grid), dim3(NTHREADS), args, LDS_BYTES, stream);
    if (e != hipSuccess) fprintf(stderr, "kernel_launch: cooperative launch failed: %s (grid %d)\n", hipGetErrorString(e), grid);
}
```
